# Optimizing an MI355X kernel written in HIP

```python
import jax, jax.numpy as jnp
from jax import lax
import numpy as np

D_MODEL = 2048
BATCH = 2
SEQ = 4096
DEPTH = 1

GM_WIDTH = D_MODEL // 2
GM_GROUP_DIM = 128
GM_GROUPS = GM_WIDTH // GM_GROUP_DIM
GM_CHUNK = 128
ML_HEADS = 4
ML_HEAD_DIM = (D_MODEL // 2) // ML_HEADS
ML_WIDTH = ML_HEADS * ML_HEAD_DIM
ML_CHUNK = 128
CONV_K = 4
D_FF = 4 * D_MODEL
EPS = 1e-6
IN_WIDTHS = (GM_WIDTH, GM_WIDTH, ML_WIDTH, ML_WIDTH, ML_WIDTH, ML_HEADS, ML_HEADS, D_MODEL, D_MODEL)
N_IN = 2 * GM_WIDTH + 3 * ML_WIDTH + 2 * ML_HEADS + 2 * D_MODEL

kernel_name = "hybrid_gmlp_mlstm_gated_block"


def _rms_norm(x, g):
    xf = x.astype(jnp.float32)
    y = xf * lax.rsqrt(jnp.mean(xf * xf, axis=-1, keepdims=True) + EPS)
    return (y * g.astype(jnp.float32)).astype(x.dtype)


def _layer_norm(x, g, b):
    xf = x.astype(jnp.float32)
    mu = jnp.mean(xf, axis=-1, keepdims=True)
    var = jnp.mean(jnp.square(xf - mu), axis=-1, keepdims=True)
    y = (xf - mu) * lax.rsqrt(var + EPS)
    return (y * g.astype(jnp.float32) + b.astype(jnp.float32)).astype(x.dtype)


def _gmlp_mixer(u, v, ln_g, ln_b, ws, bs):
    B, S, _ = u.shape
    u = jax.nn.gelu(u)
    v = _layer_norm(jax.nn.gelu(v), ln_g, ln_b)
    nc = S // GM_CHUNK
    vc = v.reshape(B, nc, GM_CHUNK, GM_GROUPS, GM_GROUP_DIM)
    causal = jnp.tril(jnp.ones((GM_CHUNK, GM_CHUNK), dtype=bool))
    ws_c = jnp.where(causal[None], ws, jnp.zeros_like(ws))
    s = jnp.einsum('gts,bnsgc->bntgc', ws_c, vc) + bs.T[:, :, None]
    return u * s.reshape(B, S, GM_WIDTH)


def _causal_conv(x, w, b):
    S = x.shape[1]
    xp = jnp.pad(x, ((0, 0), (CONV_K - 1, 0), (0, 0)))
    out = b
    for j in range(CONV_K):
        out = out + w[j] * xp[:, j:j + S]
    return out


def _mlstm_mixer(m_in, v_in, o_in, i_pre, f_pre, conv_w, conv_b, wq, wk, ig_b, fg_b, norm_g):
    B, S, _ = m_in.shape
    H, Dh, L = ML_HEADS, ML_HEAD_DIM, ML_CHUNK
    nc = S // L
    f32 = jnp.float32
    c = jax.nn.silu(_causal_conv(m_in, conv_w, conv_b)).reshape(B, S, H, Dh)
    q = jnp.einsum('bshd,hde->bhse', c, wq).astype(f32)
    k = (jnp.einsum('bshd,hde->bhse', c, wk) * (Dh ** -0.5)).astype(f32)
    v = v_in.reshape(B, S, H, Dh).transpose(0, 2, 1, 3).astype(f32)
    ig = (i_pre + ig_b).astype(f32).transpose(0, 2, 1)
    logf = jax.nn.log_sigmoid((f_pre + fg_b).astype(f32)).transpose(0, 2, 1)
    q = q.reshape(B, H, nc, L, Dh)
    k = k.reshape(B, H, nc, L, Dh)
    v = v.reshape(B, H, nc, L, Dh)
    ig = ig.reshape(B, H, nc, L)
    bcum = jnp.cumsum(logf.reshape(B, H, nc, L), axis=-1)
    b_last = bcum[..., -1]
    a = b_last[..., None] - bcum + ig
    a_max = jnp.max(a, axis=-1)
    wa = jnp.exp(a - a_max[..., None])
    kv = jnp.einsum('bhnl,bhnld,bhnle->bhnde', wa, k, v)
    ksum = jnp.einsum('bhnl,bhnld->bhnd', wa, k)

    def step(carry, inp):
        C, n, m = carry
        kv_c, ks_c, bl_c, am_c = inp
        m_new = jnp.maximum(bl_c + m, am_c)
        decay = jnp.exp(bl_c + m - m_new)
        scale = jnp.exp(am_c - m_new)
        C_new = decay[..., None, None] * C + scale[..., None, None] * kv_c
        n_new = decay[..., None] * n + scale[..., None] * ks_c
        return (C_new, n_new, m_new), (C, n, m)

    init = (jnp.zeros((B, H, Dh, Dh), f32), jnp.zeros((B, H, Dh), f32), jnp.zeros((B, H), f32))
    xs = (jnp.moveaxis(kv, 2, 0), jnp.moveaxis(ksum, 2, 0), jnp.moveaxis(b_last, 2, 0), jnp.moveaxis(a_max, 2, 0))
    _, (C_prev, n_prev, m_prev) = lax.scan(step, init, xs)
    C_prev = jnp.moveaxis(C_prev, 0, 2)
    n_prev = jnp.moveaxis(n_prev, 0, 2)
    m_prev = jnp.moveaxis(m_prev, 0, 2)

    causal = jnp.tril(jnp.ones((L, L), dtype=bool))
    Dlog = bcum[..., :, None] - bcum[..., None, :] + ig[..., None, :]
    Dlog = jnp.where(causal, Dlog, -jnp.inf)
    inter = bcum + m_prev[..., None]
    m_t = jnp.maximum(inter, jnp.max(Dlog, axis=-1))
    w_intra = jnp.exp(Dlog - m_t[..., None])
    w_inter = jnp.exp(inter - m_t)
    qk = jnp.einsum('bhntd,bhnsd->bhnts', q, k) * w_intra
    num = (w_inter[..., None] * jnp.einsum('bhntd,bhnde->bhnte', q, C_prev)
           + jnp.einsum('bhnts,bhnse->bhnte', qk, v))
    den = w_inter * jnp.einsum('bhntd,bhnd->bhnt', q, n_prev) + jnp.sum(qk, axis=-1)
    h = num / jnp.maximum(jnp.abs(den), jnp.exp(-m_t))[..., None]
    h = h.reshape(B, H, S, Dh).transpose(0, 2, 1, 3)
    mu = jnp.mean(h, axis=-1, keepdims=True)
    var = jnp.mean(jnp.square(h - mu), axis=-1, keepdims=True)
    h = ((h - mu) * lax.rsqrt(var + EPS)).reshape(B, S, ML_WIDTH) * norm_g.astype(f32)
    return (jax.nn.sigmoid(o_in.astype(f32)) * h).astype(m_in.dtype)


def setup_inputs(seed: int = 0) -> dict:
    key = jax.random.key(seed)
    ks = jax.random.split(key, 24)
    nrm = lambda k, shape, s: jax.random.normal(k, shape, jnp.float32) * s
    Ld = DEPTH
    return {
        "x": jax.random.normal(ks[0], (BATCH, SEQ, D_MODEL), jnp.float32),
        "norm1_g": 1.0 + nrm(ks[1], (Ld, D_MODEL), 0.02),
        "w_in": nrm(ks[2], (Ld, D_MODEL, N_IN), D_MODEL ** -0.5),
        "b_gate": nrm(ks[3], (Ld, 2, D_MODEL), 0.02),
        "gm_ln_g": 1.0 + nrm(ks[4], (Ld, GM_WIDTH), 0.02),
        "gm_ln_b": nrm(ks[5], (Ld, GM_WIDTH), 0.02),
        "gm_ws": nrm(ks[6], (Ld, GM_GROUPS, GM_CHUNK, GM_CHUNK), GM_CHUNK ** -0.5),
        "gm_bs": 1.0 + nrm(ks[7], (Ld, GM_GROUPS, GM_CHUNK), 0.02),
        "ml_conv_w": nrm(ks[8], (Ld, CONV_K, ML_WIDTH), CONV_K ** -0.5),
        "ml_conv_b": nrm(ks[9], (Ld, ML_WIDTH), 0.02),
        "ml_wq": nrm(ks[10], (Ld, ML_HEADS, ML_HEAD_DIM, ML_HEAD_DIM), ML_HEAD_DIM ** -0.5),
        "ml_wk": nrm(ks[11], (Ld, ML_HEADS, ML_HEAD_DIM, ML_HEAD_DIM), ML_HEAD_DIM ** -0.5),
        "ml_ig_b": nrm(ks[12], (Ld, ML_HEADS), 0.1),
        "ml_fg_b": jnp.linspace(3.0, 6.0, ML_HEADS, dtype=jnp.float32)[None] + nrm(ks[13], (Ld, ML_HEADS), 0.1),
        "ml_norm_g": 1.0 + nrm(ks[14], (Ld, ML_WIDTH), 0.02),
        "w_a": nrm(ks[15], (Ld, GM_WIDTH, D_MODEL), GM_WIDTH ** -0.5),
        "w_b": nrm(ks[16], (Ld, ML_WIDTH, D_MODEL), ML_WIDTH ** -0.5),
        "w_out": nrm(ks[17], (Ld, D_MODEL, D_MODEL), D_MODEL ** -0.5),
        "norm2_g": 1.0 + nrm(ks[18], (Ld, D_MODEL), 0.02),
        "w_ff1": nrm(ks[19], (Ld, D_MODEL, D_FF), D_MODEL ** -0.5),
        "w_ff2": nrm(ks[20], (Ld, D_FF, D_MODEL), D_FF ** -0.5),
        "norm_f_g": 1.0 + nrm(ks[21], (D_MODEL,), 0.02),
    }


def reference(x, norm1_g, w_in, b_gate, gm_ln_g, gm_ln_b, gm_ws, gm_bs, ml_conv_w, ml_conv_b,
              ml_wq, ml_wk, ml_ig_b, ml_fg_b, ml_norm_g, w_a, w_b, w_out, norm2_g, w_ff1, w_ff2,
              norm_f_g):
    split_idx = [int(i) for i in np.cumsum(IN_WIDTHS)[:-1]]
    for l in range(DEPTH):
        xn = _rms_norm(x, norm1_g[l])
        proj = xn @ w_in[l]
        gm_u, gm_v, ml_m, ml_v, ml_o, ml_i, ml_f, g_a, g_b = jnp.split(proj, split_idx, axis=-1)
        y_a = _gmlp_mixer(gm_u, gm_v, gm_ln_g[l], gm_ln_b[l], gm_ws[l], gm_bs[l])
        y_b = _mlstm_mixer(ml_m, ml_v, ml_o, ml_i, ml_f, ml_conv_w[l], ml_conv_b[l], ml_wq[l],
                           ml_wk[l], ml_ig_b[l], ml_fg_b[l], ml_norm_g[l])
        gate_a = jax.nn.sigmoid(g_a + b_gate[l, 0])
        gate_b = jax.nn.sigmoid(g_b + b_gate[l, 1])
        mixed = gate_a * (y_a @ w_a[l]) + gate_b * (y_b @ w_b[l])
        x = x + mixed @ w_out[l]
        hn = _rms_norm(x, norm2_g[l])
        x = x + jnp.square(jax.nn.relu(hn @ w_ff1[l])) @ w_ff2[l]
    return _rms_norm(x, norm_f_g)
```

```cpp
#include <hip/hip_runtime.h>
#include <cstdio>
#include <cstdint>

#ifndef MK_N_LAUNCHES
#define MK_N_LAUNCHES 1
#endif

#define DI __device__ __forceinline__
#define LAS __attribute__((address_space(3)))
#define GAS __attribute__((address_space(1)))
typedef unsigned short bf16;
typedef short bf16x8 __attribute__((ext_vector_type(8)));
typedef float f32x4 __attribute__((ext_vector_type(4)));
typedef float f32x2 __attribute__((ext_vector_type(2)));
typedef unsigned u32x4 __attribute__((ext_vector_type(4)));
typedef unsigned u32x2 __attribute__((ext_vector_type(2)));
typedef GAS unsigned gu32;

constexpr int BATCH = 2, SEQ = 4096, DM = 2048, M = BATCH * SEQ;
constexpr int GMW = 1024, GMG = 8, GMC = 128;
constexpr int MLH = 4, MLD = 256, MLW = 1024, MLC = 128, NCH = SEQ / MLC;
constexpr int DFF = 8192;
constexpr int NIN_SRC = 9224;
constexpr int NPROJ = 9216;
constexpr float EPS = 1e-6f;

DI float bf2f(unsigned v) { return __uint_as_float(v << 16); }
typedef __bf16 bf16x2_t __attribute__((ext_vector_type(2)));
DI unsigned cvt_pk_bf16(float lo, float hi) { const f32x2 v = {lo, hi}; const bf16x2_t b = __builtin_convertvector(v, bf16x2_t); return __builtin_bit_cast(unsigned, b); }
DI unsigned cvt_pk_bf16_asm(float lo, float hi) { unsigned r; asm volatile("v_cvt_pk_bf16_f32 %0, %1, %2" : "=v"(r) : "v"(lo), "v"(hi)); return r; }
DI float fexp(float x) { return __builtin_amdgcn_exp2f(x * 1.4426950408889634f); }
DI float frcp(float x) { return __builtin_amdgcn_rcpf(x); }
DI float sigmoidf_(float z) { return frcp(1.0f + fexp(-z)); }
DI float gelu_tanh(float x) { const float u = 0.7978845608028654f * (x + 0.044715f * x * x * x); return x * frcp(1.0f + fexp(-2.0f * u)); }
DI float silu_(float x) { return x * frcp(1.0f + fexp(-x)); }
DI void unpack8(const u32x4 w, float (&f)[8]) {
    f[0] = bf2f(w.x & 0xffffu); f[1] = bf2f(w.x >> 16); f[2] = bf2f(w.y & 0xffffu); f[3] = bf2f(w.y >> 16);
    f[4] = bf2f(w.z & 0xffffu); f[5] = bf2f(w.z >> 16); f[6] = bf2f(w.w & 0xffffu); f[7] = bf2f(w.w >> 16);
}
DI void unpack4(const u32x2 w, float (&f)[4]) { f[0] = bf2f(w.x & 0xffffu); f[1] = bf2f(w.x >> 16); f[2] = bf2f(w.y & 0xffffu); f[3] = bf2f(w.y >> 16); }

namespace pg8 {
#define PG8_LAS __attribute__((address_space(3)))
typedef unsigned short bf16_t;
constexpr int BM = 256, BK = 64, HALF = 128, HTB = HALF * BK * 2, STAGE_BYTES = 8 * HTB, NXCD = 8, WGM = 8;

__host__ __device__ __forceinline__ int lds_byte(int r, int c) { const int st = (r >> 4) * 2 + (c >> 5), rr = r & 15, cc = c & 31, ob = rr * 64 + cc * 2; return st * 1024 + (ob ^ (((ob >> 9) & 1) << 5)); }
__host__ __device__ __forceinline__ void stage_rc(int b, int& R, int& C) { const int st = b / 1024, sb = b % 1024, swz = sb ^ (((sb >> 9) & 1) << 5); R = (st >> 1) * 16 + swz / 64; C = (st & 1) * 32 + (swz % 64) / 2; }
__host__ __device__ __forceinline__ int perm32(int rho) { const int n = rho >> 4, i = rho & 15; return 8 * (i >> 2) + 4 * n + (i & 3); }

struct Unit { int pm, pn; };
struct Gemm { const bf16_t* A; const bf16_t* Bt; int M, N, K; };

struct StaticOrder {
    int nM, nN, nwg, G, c;
    __host__ __device__ void init(int M_, int N_, int G_, int c_) { nM = M_ / BM; nN = N_ / BM; nwg = nM * nN; G = G_; c = c_; }
    __host__ __device__ bool next(int i, Unit& u) const {
        const long L = (long)i * G + c; if (L >= nwg) return false;
        int wgid = (int)L; { const int q = nwg / NXCD, r = nwg % NXCD, xcd = wgid % NXCD, off = wgid / NXCD; wgid = (xcd < r ? xcd * (q + 1) : r * (q + 1) + (xcd - r) * q) + off; }
        const int nig = WGM * nN, gid = wgid / nig, fm = gid * WGM, gsz = (nM - fm) < WGM ? (nM - fm) : WGM;
        u.pm = fm + ((wgid % nig) % gsz); u.pn = (wgid % nig) / gsz; return true;
    }
};

typedef f32x4 Acc[2][2][4][2];

struct EpiProj {
    static constexpr bool PERM = true, HAS_MID = false;
    const float* rstd; const float* bgate; bf16_t *U, *GV, *MMb, *MVb, *MOb, *GA, *GB; float* lnstat;
    DI void mid(Acc&, const Unit&, int, int, int, int) const {}
    DI void operator()(const Acc& acc, const Unit& u, int wr, int wc, int fr, int fq) const {
        const int pn = u.pn; bf16_t* base; int ldc, ct, act; const float* bias = nullptr; bool stats = false;
        if (pn < 4) { base = U; ldc = GMW; ct = pn; act = 1; }
        else if (pn < 8) { base = GV; ldc = GMW; ct = pn - 4; act = 1; stats = true; }
        else if (pn < 12) { base = MMb; ldc = MLW; ct = pn - 8; act = 0; }
        else if (pn < 16) { base = MVb; ldc = MLW; ct = pn - 12; act = 0; }
        else if (pn < 20) { base = MOb; ldc = MLW; ct = pn - 16; act = 2; }
        else if (pn < 28) { base = GA; ldc = DM; ct = pn - 20; act = 2; bias = bgate; }
        else { base = GB; ldc = DM; ct = pn - 28; act = 2; bias = bgate + DM; }
        const int row0 = u.pm * BM + wr * 64 + fr, col0 = ct * BM + wc * 32 + 8 * fq;
        f32x4 bv[2][2];
#pragma unroll
        for (int bj = 0; bj < 2; ++bj)
#pragma unroll
            for (int n = 0; n < 2; ++n) bv[bj][n] = bias ? *(const f32x4*)(bias + col0 + bj * HALF + 4 * n) : (f32x4){0.f, 0.f, 0.f, 0.f};
#pragma unroll
        for (int ai = 0; ai < 2; ++ai)
#pragma unroll
            for (int m = 0; m < 4; ++m) {
                const int row = row0 + ai * HALF + m * 16; const float rs = rstd[row]; bf16_t* rowp = base + (size_t)row * ldc + col0;
                float s1 = 0.f, s2 = 0.f;
#pragma unroll
                for (int bj = 0; bj < 2; ++bj) {
                    f32x4 v0 = acc[ai][bj][m][0] * rs + bv[bj][0], v1 = acc[ai][bj][m][1] * rs + bv[bj][1];
                    if (act == 1) {
#pragma unroll
                        for (int e = 0; e < 4; ++e) { v0[e] = gelu_tanh(v0[e]); v1[e] = gelu_tanh(v1[e]); }
                        if (stats) {
#pragma unroll
                            for (int e = 0; e < 4; ++e) { s1 += v0[e] + v1[e]; s2 += v0[e] * v0[e] + v1[e] * v1[e]; }
                        }
                    } else if (act == 2) {
#pragma unroll
                        for (int e = 0; e < 4; ++e) { v0[e] = sigmoidf_(v0[e]); v1[e] = sigmoidf_(v1[e]); }
                    }
                    u32x4 w; w.x = cvt_pk_bf16_asm(v0[0], v0[1]); w.y = cvt_pk_bf16_asm(v0[2], v0[3]); w.z = cvt_pk_bf16_asm(v1[0], v1[1]); w.w = cvt_pk_bf16_asm(v1[2], v1[3]);
                    *(u32x4*)(rowp + bj * HALF) = w;
                }
                if (stats) {
                    s1 += __shfl_xor(s1, 16); s1 += __shfl_xor(s1, 32); s2 += __shfl_xor(s2, 16); s2 += __shfl_xor(s2, 32);
                    if (fq == 0) *(f32x2*)(lnstat + ((size_t)row * 16 + (pn - 4) * 4 + wc) * 2) = (f32x2){s1, s2};
                }
            }
    }
};

struct EpiMix {
    static constexpr bool PERM = true, HAS_MID = true;
    const bf16_t *GA, *GB; bf16_t* O;
    DI void mid(Acc& acc, const Unit& u, int wr, int wc, int fr, int fq) const {
        int opq = 0; asm volatile("" : "+v"(opq));
        const int row0 = u.pm * BM + wr * 64 + fr + opq, col0 = u.pn * BM + wc * 32 + 8 * fq;
#pragma unroll
        for (int ai = 0; ai < 2; ++ai)
#pragma unroll
            for (int m = 0; m < 4; ++m) {
                const size_t off = (size_t)(row0 + ai * HALF + m * 16) * DM + col0;
#pragma unroll
                for (int bj = 0; bj < 2; ++bj) {
                    const u32x4 a = *(const u32x4*)(GA + off + bj * HALF), b = *(const u32x4*)(GB + off + bj * HALF);
                    float fa[8], fb[8]; unpack8(a, fa); unpack8(b, fb);
#pragma unroll
                    for (int e = 0; e < 4; ++e) { acc[ai][bj][m][0][e] *= fa[e] * frcp(fb[e]); acc[ai][bj][m][1][e] *= fa[4 + e] * frcp(fb[4 + e]); }
                }
            }
    }
    DI void operator()(const Acc& acc, const Unit& u, int wr, int wc, int fr, int fq) const {
        const int row0 = u.pm * BM + wr * 64 + fr, col0 = u.pn * BM + wc * 32 + 8 * fq;
#pragma unroll
        for (int ai = 0; ai < 2; ++ai)
#pragma unroll
            for (int m = 0; m < 4; ++m) {
                const size_t off = (size_t)(row0 + ai * HALF + m * 16) * DM + col0;
#pragma unroll
                for (int bj = 0; bj < 2; ++bj) {
                    const u32x4 b = *(const u32x4*)(GB + off + bj * HALF); float fb[8]; unpack8(b, fb);
                    const f32x4 v0 = acc[ai][bj][m][0], v1 = acc[ai][bj][m][1];
                    u32x4 w; w.x = cvt_pk_bf16_asm(v0[0] * fb[0], v0[1] * fb[1]); w.y = cvt_pk_bf16_asm(v0[2] * fb[2], v0[3] * fb[3]);
                    w.z = cvt_pk_bf16_asm(v1[0] * fb[4], v1[1] * fb[5]); w.w = cvt_pk_bf16_asm(v1[2] * fb[6], v1[3] * fb[7]);
                    *(u32x4*)(O + off + bj * HALF) = w;
                }
            }
    }
};

struct EpiRes {
    static constexpr bool PERM = true, HAS_MID = false;
    const float* xin; float* xo; bf16_t* xb; float* ss;
    DI void mid(Acc&, const Unit&, int, int, int, int) const {}
    DI void operator()(const Acc& acc, const Unit& u, int wr, int wc, int fr, int fq) const {
        const int row0 = u.pm * BM + wr * 64 + fr, col0 = u.pn * BM + wc * 32 + 8 * fq;
#pragma unroll
        for (int ai = 0; ai < 2; ++ai)
#pragma unroll
            for (int m = 0; m < 4; ++m) {
                const int row = row0 + ai * HALF + m * 16; const size_t off = (size_t)row * DM + col0; float s2 = 0.f;
#pragma unroll
                for (int bj = 0; bj < 2; ++bj) {
                    const f32x4 x0 = *(const f32x4*)(xin + off + bj * HALF), x1 = *(const f32x4*)(xin + off + bj * HALF + 4);
                    const f32x4 v0 = acc[ai][bj][m][0] + x0, v1 = acc[ai][bj][m][1] + x1;
                    *(f32x4*)(xo + off + bj * HALF) = v0; *(f32x4*)(xo + off + bj * HALF + 4) = v1;
                    if (xb) { u32x4 w; w.x = cvt_pk_bf16_asm(v0[0], v0[1]); w.y = cvt_pk_bf16_asm(v0[2], v0[3]); w.z = cvt_pk_bf16_asm(v1[0], v1[1]); w.w = cvt_pk_bf16_asm(v1[2], v1[3]); *(u32x4*)(xb + off + bj * HALF) = w; }
#pragma unroll
                    for (int e = 0; e < 4; ++e) s2 += v0[e] * v0[e] + v1[e] * v1[e];
                }
                if (ss) { s2 += __shfl_xor(s2, 16); s2 += __shfl_xor(s2, 32); if (fq == 0) ss[(size_t)row * 32 + u.pn * 4 + wc] = s2; }
            }
    }
};

struct EpiFF1 {
    static constexpr bool PERM = true, HAS_MID = false;
    const float* ss; bf16_t* H;
    DI void mid(Acc&, const Unit&, int, int, int, int) const {}
    DI void operator()(const Acc& acc, const Unit& u, int wr, int wc, int fr, int fq) const {
        const int row0 = u.pm * BM + wr * 64 + fr, col0 = u.pn * BM + wc * 32 + 8 * fq;
#pragma unroll
        for (int ai = 0; ai < 2; ++ai)
#pragma unroll
            for (int m = 0; m < 4; ++m) {
                const int row = row0 + ai * HALF + m * 16;
                const f32x4 p0 = *(const f32x4*)(ss + (size_t)row * 32 + 8 * fq), p1 = *(const f32x4*)(ss + (size_t)row * 32 + 8 * fq + 4);
                float s = ((p0[0] + p0[1]) + (p0[2] + p0[3])) + ((p1[0] + p1[1]) + (p1[2] + p1[3]));
                s += __shfl_xor(s, 16); s += __shfl_xor(s, 32);
                const float rs = __builtin_amdgcn_rsqf(s * (1.0f / DM) + EPS);
                bf16_t* rowp = H + (size_t)row * DFF + col0;
#pragma unroll
                for (int bj = 0; bj < 2; ++bj) {
                    f32x4 v0 = acc[ai][bj][m][0] * rs, v1 = acc[ai][bj][m][1] * rs;
#pragma unroll
                    for (int e = 0; e < 4; ++e) { const float a = fmaxf(v0[e], 0.f), b = fmaxf(v1[e], 0.f); v0[e] = a * a; v1[e] = b * b; }
                    u32x4 w; w.x = cvt_pk_bf16_asm(v0[0], v0[1]); w.y = cvt_pk_bf16_asm(v0[2], v0[3]); w.z = cvt_pk_bf16_asm(v1[0], v1[1]); w.w = cvt_pk_bf16_asm(v1[2], v1[3]);
                    *(u32x4*)(rowp + bj * HALF) = w;
                }
            }
    }
};

template <class Epi, class Sched, bool ALIGN_EPI>
DI void gemm_phase(PG8_LAS unsigned char* lds, const Gemm g, const Sched& S, const Epi& E) {
    const int tid = threadIdx.x, wid = __builtin_amdgcn_readfirstlane(tid >> 6), lane = tid & 63, wr = wid >> 2, wc = wid & 3, fr = lane & 15, fq = lane >> 4;
    const int K = g.K, nt = K / BK;
    unsigned voffA[2], voffB[2];
#pragma unroll
    for (int i = 0; i < 2; ++i) { int R, C; stage_rc(tid * 16 + i * 8192, R, C); const int Rb = Epi::PERM ? ((R & ~31) + perm32(R & 31)) : R;
        voffA[i] = (unsigned)(R * K + C) * 2u; voffB[i] = (unsigned)(Rb * K + C) * 2u; }
    const size_t kstep = (size_t)(BK * 2);
    const size_t hstep = (size_t)HALF * K * 2;
    const size_t tstep = 2 * hstep;
    const unsigned ldsw = (unsigned)wid * 1024u;
    const int aoff = lds_byte(wr * 64 + fr, fq * 8), boff = lds_byte(wc * 32 + fr, fq * 8);
#define PG8_SA(b, h) (((b) * 2 + (h)) * HTB)
#define PG8_SB(b, h) ((4 + (b) * 2 + (h)) * HTB)
#define PG8_STAGE(bufoff, gbase, voff) do { _Pragma("unroll") for (int _i = 0; _i < 2; ++_i) \
        __builtin_amdgcn_global_load_lds((const unsigned*)((const char*)(gbase) + (voff)[_i]), (PG8_LAS unsigned*)(lds + (bufoff) + ldsw + _i * 8192), 16, 0, 0); } while (0)
#define PG8_LDA(dst, b, h) do { _Pragma("unroll") for (int m = 0; m < 4; ++m) _Pragma("unroll") for (int k = 0; k < 2; ++k) dst[m][k] = *(const PG8_LAS bf16x8*)(lds + PG8_SA(b, h) + aoff + m * 2048 + k * 1024); } while (0)
#define PG8_LDB(dst, b, h) do { _Pragma("unroll") for (int n = 0; n < 2; ++n) _Pragma("unroll") for (int k = 0; k < 2; ++k) dst[n][k] = *(const PG8_LAS bf16x8*)(lds + PG8_SB(b, h) + boff + n * 2048 + k * 1024); } while (0)
#define PG8_MMA(ai, bj, At, Bt) do { __builtin_amdgcn_s_setprio(1); _Pragma("unroll") for (int m = 0; m < 4; ++m) _Pragma("unroll") for (int n = 0; n < 2; ++n) _Pragma("unroll") for (int k = 0; k < 2; ++k) \
        acc[ai][bj][m][n] = __builtin_amdgcn_mfma_f32_16x16x32_bf16(Bt[n][k], At[m][k], acc[ai][bj][m][n], 0, 0, 0); __builtin_amdgcn_s_setprio(0); } while (0)
#define PG8_WAIT_V(n) asm volatile("s_waitcnt vmcnt(" #n ")" ::: "memory")
#define PG8_WAIT_L(n) asm volatile("s_waitcnt lgkmcnt(" #n ")" ::: "memory")
#define PG8_BAR __builtin_amdgcn_s_barrier()
#define PG8_SCHED __builtin_amdgcn_sched_barrier(0)
    Unit cur, nxt; int ui = 0;
    if (!S.next(0, cur)) return;
    Acc acc;
#pragma unroll
    for (int a = 0; a < 2; ++a)
#pragma unroll
        for (int b = 0; b < 2; ++b)
#pragma unroll
            for (int m = 0; m < 4; ++m)
#pragma unroll
                for (int n = 0; n < 2; ++n) acc[a][b][m][n] = (f32x4){0.f, 0.f, 0.f, 0.f};
    bf16x8 At[4][2], B0[2][2], B1[2][2];
    const char* cA = (const char*)g.A + (size_t)cur.pm * tstep; const char* cB = (const char*)g.Bt + (size_t)cur.pn * tstep;
    PG8_STAGE(PG8_SB(0, 0), cB, voffB); PG8_STAGE(PG8_SB(0, 1), cB + hstep, voffB); PG8_STAGE(PG8_SA(0, 0), cA, voffA); PG8_STAGE(PG8_SA(0, 1), cA + hstep, voffA);
    if (wr == 1) PG8_BAR;
    PG8_WAIT_V(2); PG8_BAR;
    PG8_STAGE(PG8_SB(1, 0), cB + kstep, voffB); PG8_STAGE(PG8_SA(1, 0), cA + kstep, voffA); PG8_STAGE(PG8_SB(1, 1), cB + hstep + kstep, voffB);
    PG8_WAIT_V(6); PG8_BAR;
    for (;;) {
        const bool has_next = S.next(ui + 1, nxt);
        const char* nA = has_next ? (const char*)g.A + (size_t)nxt.pm * tstep : cA; const char* nB = has_next ? (const char*)g.Bt + (size_t)nxt.pn * tstep : cB;
        for (int t = 0; t < nt; t += 2) {
            const bool last = (t == nt - 2);
            const char* a1 = cA + (size_t)(t + 1) * kstep;
            const char* a2 = last ? nA : cA + (size_t)(t + 2) * kstep; const char* b2 = last ? nB : cB + (size_t)(t + 2) * kstep;
            const char* a3 = a2 + kstep; const char* b3 = b2 + kstep;
            if constexpr (Epi::HAS_MID) { if (t == (nt >> 1)) E.mid(acc, cur, wr, wc, fr, fq); }
            PG8_LDB(B0, 0, 0); PG8_LDB(B1, 0, 1); PG8_SCHED; PG8_LDA(At, 0, 0); PG8_STAGE(PG8_SA(1, 1), a1 + hstep, voffA);
            PG8_WAIT_V(8); PG8_WAIT_L(0); PG8_BAR; PG8_MMA(0, 0, At, B0); PG8_MMA(0, 1, At, B1); PG8_BAR; PG8_SCHED;
            PG8_LDA(At, 0, 1); PG8_STAGE(PG8_SB(0, 0), b2, voffB); PG8_STAGE(PG8_SB(0, 1), b2 + hstep, voffB); PG8_STAGE(PG8_SA(0, 0), a2, voffA);
            PG8_WAIT_V(8); PG8_WAIT_L(0); PG8_BAR; PG8_MMA(1, 0, At, B0); PG8_MMA(1, 1, At, B1); PG8_BAR; PG8_SCHED;
            PG8_LDB(B0, 1, 0); PG8_LDB(B1, 1, 1); PG8_SCHED; PG8_LDA(At, 1, 0); PG8_STAGE(PG8_SA(0, 1), a2 + hstep, voffA);
            PG8_WAIT_V(8); PG8_WAIT_L(0); PG8_BAR; PG8_MMA(0, 0, At, B0); PG8_MMA(0, 1, At, B1); PG8_BAR; PG8_SCHED;
            PG8_LDA(At, 1, 1); PG8_STAGE(PG8_SB(1, 0), b3, voffB); PG8_STAGE(PG8_SB(1, 1), b3 + hstep, voffB); PG8_STAGE(PG8_SA(1, 0), a3, voffA);
            PG8_WAIT_V(8); PG8_WAIT_L(0); PG8_BAR; PG8_MMA(1, 0, At, B0); PG8_MMA(1, 1, At, B1); PG8_BAR; PG8_SCHED;
        }
        if constexpr (ALIGN_EPI) { if (wr == 0) PG8_BAR; }
        E(acc, cur, wr, wc, fr, fq);
        if (!has_next) break;
#pragma unroll
        for (int a = 0; a < 2; ++a)
#pragma unroll
            for (int b = 0; b < 2; ++b)
#pragma unroll
                for (int m = 0; m < 4; ++m)
#pragma unroll
                    for (int n = 0; n < 2; ++n) acc[a][b][m][n] = (f32x4){0.f, 0.f, 0.f, 0.f};
        cur = nxt; cA = nA; cB = nB; ++ui;
        if constexpr (ALIGN_EPI) { if (wr == 1) PG8_BAR; }
    }
    PG8_WAIT_V(0);
    if constexpr (!ALIGN_EPI) { if (wr == 0) PG8_BAR; }
    PG8_BAR;
#undef PG8_SA
#undef PG8_SB
#undef PG8_STAGE
#undef PG8_LDA
#undef PG8_LDB
#undef PG8_MMA
#undef PG8_WAIT_V
#undef PG8_WAIT_L
#undef PG8_BAR
#undef PG8_SCHED
}
}

constexpr size_t MiB = 1u << 20;
constexpr size_t WS_CTL = 0, CTL_ZERO_BYTES = 64 * 1024;
constexpr size_t WS_RSTD1 = 1 * MiB;
constexpr size_t WS_GATES = 1 * MiB + 64 * 1024;
constexpr size_t WS_LNSTAT = 2 * MiB;
constexpr size_t WS_X1SS = 3 * MiB;
constexpr size_t WS_KSUM = 4 * MiB;
constexpr size_t WS_NPREV = 4 * MiB + 256 * 1024;
constexpr size_t WS_DENI = 4 * MiB + 512 * 1024;
constexpr size_t WS_WQT = 8 * MiB, WS_WKT = 8 * MiB + 512 * 1024;
constexpr size_t WS_WAB = 9 * MiB;
constexpr size_t WS_WOUT = 17 * MiB;
constexpr size_t WS_WFF1 = 25 * MiB;
constexpr size_t WS_WFF2 = 57 * MiB;
constexpr size_t WS_A = 89 * MiB;
constexpr size_t WS_WIN = WS_A, WS_Q = WS_A, WS_K = WS_A + 16 * MiB, WS_MIXED = WS_A;
constexpr size_t WS_C = 125 * MiB;
constexpr size_t WS_U = WS_C, WS_GV = WS_C + 16 * MiB, WS_MM = WS_C + 32 * MiB, WS_MV = WS_C + 48 * MiB, WS_MO = WS_C + 64 * MiB;
constexpr size_t WS_CT = WS_U;
constexpr size_t WS_INTRA = WS_MM;
constexpr size_t WS_D = 205 * MiB;
constexpr size_t WS_GA = WS_D, WS_GB = WS_D + 32 * MiB;
constexpr size_t WS_X1B = WS_D + 32 * MiB;
constexpr size_t WS_H = WS_A;
constexpr size_t WS_END = 269 * MiB;
static_assert(WS_H + (size_t)M * DFF * 2 <= WS_X1B, "h overlay must not reach X1B");
constexpr size_t OUT_Y = 0, OUT_XB = 32 * MiB, OUT_KVT = 32 * MiB;

constexpr int CW_TMO = 0, CW_BAR = 1024;

constexpr int R1_OFF = 0, R2_OFF = 69632, SM_OFF = 139264, MISC_OFF = 147456, LDS_BYTES = 149504;
constexpr int P264 = 264, P136 = 136;
static_assert(128 * 264 * 2 <= R2_OFF - R1_OFF && 256 * 136 * 2 <= R2_OFF - R1_OFF && 256 * 136 * 2 <= SM_OFF - R2_OFF && SM_OFF + 8192 <= MISC_OFF && MISC_OFF + 256 <= LDS_BYTES && R2_OFF + 8 * 2048 * 4 <= SM_OFF && 8 * 64 * 33 * 4 <= R2_OFF && pg8::STAGE_BYTES <= SM_OFF, "LDS map");
constexpr int S_BCUM = 0, S_IG = 128, S_WA = 256, S_MT = 384, S_WINT = 512, S_COLT = 640, S_ROWT = 768, S_DEN = 896, S_BL = 1024, S_AM = 1056, S_MPREV = 1088, S_DECAY = 1120, S_SCALE = 1152,
              S_QN = 1280, S_NPREV = 1408, S_STAT = 1664;

#define XB_TMO      128
#define XB_XCNT(j)  (256  + 64 * (j))
#define XB_XSUB(j)  (1280 + 64 * (j))
#define XB_XGEN(j)  (2304 + 64 * (j))
#define XB_TOP      3328
#define XB_TOPGEN   3392
#define XCD_BAR_WORDS 3456
#define XB_SPIN_CAP (1u << 20)
DI unsigned xb_ld(unsigned* p)              { return __hip_atomic_load(p, __ATOMIC_RELAXED, __HIP_MEMORY_SCOPE_AGENT); }
DI unsigned xb_add(unsigned* p, unsigned v) { return __hip_atomic_fetch_add(p, v, __ATOMIC_RELAXED, __HIP_MEMORY_SCOPE_AGENT); }
DI unsigned xb_xcc_id() { return (unsigned)__builtin_amdgcn_s_getreg((3 << 11) | 20) & 0xFu; }
#define XB_SPIN(cond, bar) do { unsigned _sp = 0; while (cond) { __builtin_amdgcn_s_sleep(1); \
    if ((++_sp & 255u) == 0u) { if (xb_ld(&(bar)[XB_TMO])) break; if (_sp > XB_SPIN_CAP) { atomicAdd(&(bar)[XB_TMO], 1u); break; } } } } while (0)
struct XcdBarrier { unsigned* bar; unsigned x; volatile LAS unsigned* st; };
DI XcdBarrier xcd_barrier_post(unsigned* bar, volatile LAS unsigned* st) {
    XcdBarrier b; b.bar = bar; b.x = xb_xcc_id(); b.st = st;
    if (threadIdx.x == 0) (void)xb_add(&bar[XB_XCNT(b.x)], 1u);
    return b;
}
DI void xcd_barrier_complete(unsigned* bar, unsigned x, unsigned& nloc, unsigned& nx) {
    const unsigned G = gridDim.x * gridDim.y * gridDim.z;
    unsigned sum, cnt, mine, sp = 0u;
    for (;;) {
        sum = 0u; cnt = 0u; mine = 0u;
#pragma unroll
        for (unsigned j = 0; j < 16; ++j) { const unsigned c = xb_ld(&bar[XB_XCNT(j)]); sum += c; cnt += (c > 0u) ? 1u : 0u; mine = (j == x) ? c : mine; }
        if (sum == G) break;
        __builtin_amdgcn_s_sleep(1);
        if ((++sp & 255u) == 0u) { if (xb_ld(&bar[XB_TMO])) break; if (sp > XB_SPIN_CAP) { atomicAdd(&bar[XB_TMO], 1u); break; } }
    }
    nloc = mine > 0u ? mine : 1u; nx = cnt > 0u ? cnt : 1u;
}
DI void xcd_barrier(const XcdBarrier& b) {
    asm volatile("s_waitcnt vmcnt(0)" ::: "memory");
    __syncthreads();
    if (threadIdx.x == 0) {
        unsigned* bar = b.bar;
        __builtin_amdgcn_s_waitcnt(0);
        unsigned nloc = b.st[0], nx = b.st[1];
        if (nloc == 0u) { xcd_barrier_complete(bar, b.x, nloc, nx); b.st[0] = nloc; b.st[1] = nx; }
        const unsigned old = xb_add(&bar[XB_XSUB(b.x)], 1u);
        const unsigned gen = old / nloc;
        if (old + 1u == (gen + 1u) * nloc) {
            __builtin_amdgcn_fence(__ATOMIC_RELEASE, "agent");
            asm volatile("s_waitcnt vmcnt(0)" ::: "memory");
            const unsigned og = xb_add(&bar[XB_TOP], 1u);
            const unsigned tg = og / nx;
            if (og + 1u == (tg + 1u) * nx) xb_add(&bar[XB_TOPGEN], 1u);
            else XB_SPIN(xb_ld(&bar[XB_TOPGEN]) == tg, bar);
            __builtin_amdgcn_fence(__ATOMIC_ACQUIRE, "agent");
            xb_add(&bar[XB_XGEN(b.x)], 1u);
            asm volatile("s_waitcnt vmcnt(0)" ::: "memory");
        } else {
            XB_SPIN(xb_ld(&bar[XB_XGEN(b.x)]) == gen, bar);
            __builtin_amdgcn_fence(__ATOMIC_ACQUIRE, "agent");
            asm volatile("s_waitcnt vmcnt(0)" ::: "memory");
        }
    }
    __syncthreads();
}

struct Ptrs {
    const float *x, *norm1_g, *w_in, *b_gate, *gm_ln_g, *gm_ln_b, *gm_ws, *gm_bs, *conv_w, *conv_b, *wq, *wk, *ig_b, *fg_b, *ml_norm_g, *w_a, *w_b, *w_out, *norm2_g, *w_ff1, *w_ff2, *norm_f_g;
    float* out; unsigned char* ws;
};
struct Frame { LAS unsigned char* lds; int tid, lane, wave, vcu, G; };
DI float wave_sum(float v) {
#pragma unroll
    for (int o = 1; o < 64; o <<= 1) v += __shfl_xor(v, o);
    return v;
}
DI float wave_max(float v) {
#pragma unroll
    for (int o = 1; o < 64; o <<= 1) v = fmaxf(v, __shfl_xor(v, o));
    return v;
}
#define LDS_WAIT() asm volatile("s_waitcnt lgkmcnt(0)" ::: "memory")

DI void p0_transpose_item(const float* W, int ldw, int k0, int c0, bf16* WT, int ldt, int r0, int kd0, const float* kscale, float mul, LAS float* scr, int lane) {
#pragma unroll 8
    for (int i = 0; i < 32; ++i) { const int kk = 2 * i + (lane >> 5); float v = W[(size_t)(k0 + kk) * ldw + c0 + (lane & 31)]; v *= kscale ? kscale[k0 + kk] * mul : mul; scr[kk * 33 + (lane & 31)] = v; }
    LDS_WAIT(); asm volatile("" ::: "memory");
    const int c = lane & 7;
#pragma unroll
    for (int j = 0; j < 4; ++j) { const int n = (lane >> 3) + 8 * j; const LAS float* s = scr + (8 * c) * 33 + n;
        u32x4 o; o.x = cvt_pk_bf16_asm(s[0 * 33], s[1 * 33]); o.y = cvt_pk_bf16_asm(s[2 * 33], s[3 * 33]); o.z = cvt_pk_bf16_asm(s[4 * 33], s[5 * 33]); o.w = cvt_pk_bf16_asm(s[6 * 33], s[7 * 33]);
        *(GAS u32x4*)(WT + (size_t)(r0 + n) * ldt + kd0 + k0 + 8 * c) = o; }
    LDS_WAIT(); asm volatile("" ::: "memory");
}

DI void p0_prologue(const Frame& F, const Ptrs& P) {
    LAS float* scr = (LAS float*)(F.lds) + F.wave * (64 * 33);
    LAS float* WG = (LAS float*)(F.lds + R2_OFF);
    unsigned char* ws = P.ws;
    for (int i = F.tid; i < DM * 8; i += 512) { const int k = i >> 3, j = i & 7; WG[j * DM + k] = P.w_in[(size_t)k * NIN_SRC + 5120 + j] * P.norm1_g[k]; }
    __syncthreads();
    const int gw = F.vcu * 8 + F.wave, NGW = F.G * 8;
    {
        bf16* XB = (bf16*)((unsigned char*)P.out + OUT_XB); float* RSTD = (float*)(ws + WS_RSTD1); float* GATES = (float*)(ws + WS_GATES);
        for (int m = gw; m < M; m += NGW) {
            const GAS f32x4* xr = (const GAS f32x4*)(P.x + (size_t)m * DM) + F.lane;
            f32x4 v[8]; float s2 = 0.f;
#pragma unroll
            for (int j = 0; j < 8; ++j) { v[j] = xr[64 * j]; s2 += (v[j].x * v[j].x + v[j].y * v[j].y) + (v[j].z * v[j].z + v[j].w * v[j].w); }
            const float rstd = __builtin_amdgcn_rsqf(wave_sum(s2) * (1.f / DM) + EPS);
            GAS u32x2* o8 = (GAS u32x2*)(XB + (size_t)m * DM) + F.lane;
#pragma unroll
            for (int j = 0; j < 8; ++j) { u32x2 w; w.x = cvt_pk_bf16_asm(v[j].x, v[j].y); w.y = cvt_pk_bf16_asm(v[j].z, v[j].w); o8[64 * j] = w; }
            float gsum[8];
#pragma unroll
            for (int g = 0; g < 8; ++g) { float a = 0.f;
#pragma unroll
                for (int j = 0; j < 8; ++j) { const f32x4 w = *(const LAS f32x4*)(WG + g * DM + 256 * j + 4 * F.lane); a += (v[j].x * w.x + v[j].y * w.y) + (v[j].z * w.z + v[j].w * w.w); }
                gsum[g] = wave_sum(a) * rstd; }
            if (F.lane == 0) { RSTD[m] = rstd; *(GAS f32x4*)(GATES + (size_t)m * 8) = (f32x4){gsum[0], gsum[1], gsum[2], gsum[3]}; *(GAS f32x4*)(GATES + (size_t)m * 8 + 4) = (f32x4){gsum[4], gsum[5], gsum[6], gsum[7]}; }
        }
    }
    int base = 0;
#define P0_JOB(W_, ldw_, K_, ncols_, c0_, WT_, ldt_, r0_, kd0_, ks_) do { const int nblk = (ncols_) / 32, items = ((K_) / 64) * nblk; \
        int first = gw - (base % NGW); if (first < 0) first += NGW; \
        for (int it = first; it < items; it += NGW) { const int kb = it / nblk, nb = it % nblk; \
            p0_transpose_item((W_), (ldw_), 64 * kb, (c0_) + 32 * nb, (WT_), (ldt_), (r0_) + 32 * nb, (kd0_), (ks_), 1.f, scr, F.lane); } \
        base += items; } while (0)
    P0_JOB(P.w_in, NIN_SRC, DM, 5120, 0, (bf16*)(ws + WS_WIN), DM, 0, 0, P.norm1_g);
    P0_JOB(P.w_in, NIN_SRC, DM, 4096, 5128, (bf16*)(ws + WS_WIN), DM, 5120, 0, P.norm1_g);
    P0_JOB(P.w_a, DM, GMW, DM, 0, (bf16*)(ws + WS_WAB), DM, 0, 0, (const float*)nullptr);
    P0_JOB(P.w_b, DM, MLW, DM, 0, (bf16*)(ws + WS_WAB), DM, 0, GMW, (const float*)nullptr);
    P0_JOB(P.w_out, DM, DM, DM, 0, (bf16*)(ws + WS_WOUT), DM, 0, 0, (const float*)nullptr);
    P0_JOB(P.w_ff1, DFF, DM, DFF, 0, (bf16*)(ws + WS_WFF1), DM, 0, 0, P.norm2_g);
    P0_JOB(P.w_ff2, DM, DFF, DM, 0, (bf16*)(ws + WS_WFF2), DFF, 0, 0, (const float*)nullptr);
#undef P0_JOB
    for (int it = gw; it < 2 * MLH * 4 * 8; it += NGW) {
        const int mat = it / (MLH * 32), r = it % (MLH * 32), h = r / 32, kb = (r % 32) / 8, nb = r % 8;
        const float* W = (mat ? P.wk : P.wq) + (size_t)h * MLD * MLD; bf16* WT = (bf16*)(ws + (mat ? WS_WKT : WS_WQT)) + (size_t)h * MLD * MLD;
        p0_transpose_item(W, MLD, 64 * kb, 32 * nb, WT, MLD, 32 * nb, 0, nullptr, mat ? 0.0625f : 1.f, scr, F.lane);
    }
}

template <int MT, int NT>
DI void lds_mma_t(f32x4 (&acc)[MT][NT], const LAS bf16* A, int pa, const LAS bf16* Bt, int pb, int m0, int n0, int K, int lane) {
    const int fr = lane & 15, fq = lane >> 4;
    const LAS bf16* ap = A + (m0 + fr) * pa + 8 * fq; const LAS bf16* bp = Bt + (n0 + fr) * pb + 8 * fq;
    for (int k0 = 0; k0 < K; k0 += 32) {
        bf16x8 a[MT], b[NT];
#pragma unroll
        for (int mi = 0; mi < MT; ++mi) a[mi] = *(const LAS bf16x8*)(ap + mi * 16 * pa + k0);
#pragma unroll
        for (int ni = 0; ni < NT; ++ni) b[ni] = *(const LAS bf16x8*)(bp + ni * 16 * pb + k0);
#pragma unroll
        for (int mi = 0; mi < MT; ++mi)
#pragma unroll
            for (int ni = 0; ni < NT; ++ni) acc[mi][ni] = __builtin_amdgcn_mfma_f32_16x16x32_bf16(b[ni], a[mi], acc[mi][ni], 0, 0, 0);
    }
}
template <int MT, int NT> DI void zero_acc(f32x4 (&acc)[MT][NT]) {
#pragma unroll
    for (int a = 0; a < MT; ++a)
#pragma unroll
        for (int b = 0; b < NT; ++b) acc[a][b] = (f32x4){0.f, 0.f, 0.f, 0.f};
}
DI void load_tile256(LAS bf16* dst, const bf16* src, int ldg, int rows, int tid) {
    for (int i = tid; i < rows * 32; i += 512) { const int r = i >> 5, c = i & 31; *(LAS u32x4*)(dst + r * P264 + 8 * c) = *(const u32x4*)(src + (size_t)r * ldg + 8 * c); }
}

DI void gates_setup(const Frame& F, const Ptrs& P, LAS float* SM, int b, int h, int nlast, int nfull) {
    const float* GATES = (const float*)(P.ws + WS_GATES); const float igb = P.ig_b[h], fgb = P.fg_b[h];
    for (int c = F.wave; c <= nlast; c += 8) {
        const int row = b * SEQ + c * MLC + 2 * F.lane;
        const float i0 = GATES[(size_t)row * 8 + h] + igb, i1 = GATES[(size_t)(row + 1) * 8 + h] + igb;
        const float z0 = GATES[(size_t)row * 8 + 4 + h] + fgb, z1 = GATES[(size_t)(row + 1) * 8 + 4 + h] + fgb;
        const float l0 = fminf(z0, 0.f) - __logf(1.f + __expf(-fabsf(z0))), l1 = fminf(z1, 0.f) - __logf(1.f + __expf(-fabsf(z1)));
        float sc = l0 + l1;
#pragma unroll
        for (int o = 1; o < 64; o <<= 1) { const float t = __shfl_up(sc, o); if (F.lane >= o) sc += t; }
        const float bc1 = sc, bc0 = sc - l1, blast = __shfl(sc, 63);
        const float a0 = blast - bc0 + i0, a1 = blast - bc1 + i1, amax = wave_max(fmaxf(a0, a1));
        if (F.lane == 0) { SM[S_BL + c] = blast; SM[S_AM + c] = amax; }
        if (c == nfull) {
            SM[S_BCUM + 2 * F.lane] = bc0; SM[S_BCUM + 2 * F.lane + 1] = bc1; SM[S_IG + 2 * F.lane] = i0; SM[S_IG + 2 * F.lane + 1] = i1;
            SM[S_WA + 2 * F.lane] = __expf(a0 - amax); SM[S_WA + 2 * F.lane + 1] = __expf(a1 - amax);
            SM[S_COLT + 2 * F.lane] = i0 - bc0; SM[S_COLT + 2 * F.lane + 1] = i1 - bc1;
        }
    }
    __syncthreads();
    if (F.tid == 0) { float m = 0.f;
        for (int c = 0; c <= nlast; ++c) { const float bl = SM[S_BL + c], am = SM[S_AM + c]; SM[S_MPREV + c] = m; const float mn = fmaxf(bl + m, am); SM[S_DECAY + c] = __expf(bl + m - mn); SM[S_SCALE + c] = __expf(am - mn); m = mn; } }
    __syncthreads();
}
DI void gates_rows(const Frame& F, LAS float* SM, int nfull) {
    if (F.wave == 0) {
        const float mp = SM[S_MPREV + nfull];
        const float c0 = SM[S_COLT + 2 * F.lane], c1 = SM[S_COLT + 2 * F.lane + 1];
        float pm = fmaxf(c0, c1);
#pragma unroll
        for (int o = 1; o < 64; o <<= 1) { const float t = __shfl_up(pm, o); if (F.lane >= o) pm = fmaxf(pm, t); }
        float pprev = __shfl_up(pm, 1); if (F.lane == 0) pprev = -INFINITY;
        const float pm0 = fmaxf(pprev, c0), pm1 = pm;
        const float b0 = SM[S_BCUM + 2 * F.lane], b1 = SM[S_BCUM + 2 * F.lane + 1];
        const float mt0 = fmaxf(b0 + mp, b0 + pm0), mt1 = fmaxf(b1 + mp, b1 + pm1);
        SM[S_MT + 2 * F.lane] = mt0; SM[S_MT + 2 * F.lane + 1] = mt1;
        SM[S_WINT + 2 * F.lane] = __expf(b0 + mp - mt0); SM[S_WINT + 2 * F.lane + 1] = __expf(b1 + mp - mt1);
        SM[S_ROWT + 2 * F.lane] = b0 - mt0; SM[S_ROWT + 2 * F.lane + 1] = b1 - mt1;
    }
    __syncthreads();
}

DI void p2_qk_item(const Frame& F, const Ptrs& P, int item) {
    const int b = item / (MLH * NCH), h = (item / NCH) % MLH, n = item % NCH, r0 = b * SEQ + n * MLC, ch0 = h * MLD;
    LAS bf16* R1 = (LAS bf16*)(F.lds + R1_OFF); LAS bf16* R2 = (LAS bf16*)(F.lds + R2_OFF);
    const bf16* MMb = (const bf16*)(P.ws + WS_MM);
    {
        const int oc = F.tid & 31, rg = F.tid >> 5, l0 = rg * 8, ch = ch0 + 8 * oc;
        float w[4][8], cb[8];
#pragma unroll
        for (int j = 0; j < 4; ++j) { const f32x4 a = *(const f32x4*)(P.conv_w + j * MLW + ch), c = *(const f32x4*)(P.conv_w + j * MLW + ch + 4);
            w[j][0] = a.x; w[j][1] = a.y; w[j][2] = a.z; w[j][3] = a.w; w[j][4] = c.x; w[j][5] = c.y; w[j][6] = c.z; w[j][7] = c.w; }
        { const f32x4 a = *(const f32x4*)(P.conv_b + ch), c = *(const f32x4*)(P.conv_b + ch + 4); cb[0] = a.x; cb[1] = a.y; cb[2] = a.z; cb[3] = a.w; cb[4] = c.x; cb[5] = c.y; cb[6] = c.z; cb[7] = c.w; }
        float win[3][8];
#pragma unroll
        for (int i = 0; i < 3; ++i) { const int pos = n * MLC + l0 - 3 + i;
            if (pos >= 0) { const u32x4 v = *(const u32x4*)(MMb + (size_t)(r0 + l0 - 3 + i) * MLW + ch); unpack8(v, win[i]); }
            else {
#pragma unroll
                for (int e = 0; e < 8; ++e) win[i][e] = 0.f; } }
#pragma unroll
        for (int l = 0; l < 8; ++l) {
            float cur[8]; { const u32x4 v = *(const u32x4*)(MMb + (size_t)(r0 + l0 + l) * MLW + ch); unpack8(v, cur); }
            float o[8];
#pragma unroll
            for (int e = 0; e < 8; ++e) o[e] = silu_(cb[e] + w[0][e] * win[0][e] + w[1][e] * win[1][e] + w[2][e] * win[2][e] + w[3][e] * cur[e]);
            u32x4 pk; pk.x = cvt_pk_bf16(o[0], o[1]); pk.y = cvt_pk_bf16(o[2], o[3]); pk.z = cvt_pk_bf16(o[4], o[5]); pk.w = cvt_pk_bf16(o[6], o[7]);
            *(LAS u32x4*)(R1 + (l0 + l) * P264 + 8 * oc) = pk;
#pragma unroll
            for (int e = 0; e < 8; ++e) { win[0][e] = win[1][e]; win[1][e] = win[2][e]; win[2][e] = cur[e]; }
        }
    }
    const int wm = F.wave >> 1, wn = F.wave & 1, fr = F.lane & 15, fq = F.lane >> 4;
#pragma unroll 1
    for (int pass = 0; pass < 4; ++pass) {
        const int mat = pass >> 1, half = pass & 1;
        const bf16* WT = (const bf16*)(P.ws + (mat ? WS_WKT : WS_WQT)) + (size_t)h * MLD * MLD + (size_t)half * 128 * MLD;
        __syncthreads();
        load_tile256(R2, WT, MLD, 128, F.tid);
        __syncthreads();
        f32x4 acc[2][4]; zero_acc(acc);
        lds_mma_t<2, 4>(acc, R1, P264, R2, P264, 32 * wm, 64 * wn, MLD, F.lane);
        bf16* O = (bf16*)(P.ws + (mat ? WS_K : WS_Q));
#pragma unroll
        for (int mi = 0; mi < 2; ++mi)
#pragma unroll
            for (int ni = 0; ni < 4; ++ni) { const int row = r0 + 32 * wm + 16 * mi + fr, col = ch0 + half * 128 + 64 * wn + 16 * ni + 4 * fq;
                u32x2 w; w.x = cvt_pk_bf16(acc[mi][ni][0], acc[mi][ni][1]); w.y = cvt_pk_bf16(acc[mi][ni][2], acc[mi][ni][3]); *(u32x2*)(O + (size_t)row * MLW + col) = w; }
    }
    __syncthreads();
}
DI void p2_gmlp_item(const Frame& F, const Ptrs& P, int item) {
    const int b = item / (NCH * GMG), n = (item / GMG) % NCH, g = item % GMG, r0 = b * SEQ + n * GMC, c0 = g * 128;
    LAS bf16* A = (LAS bf16*)(F.lds + R1_OFF); LAS bf16* Bt = (LAS bf16*)(F.lds + R2_OFF); LAS float* SM = (LAS float*)(F.lds + SM_OFF);
    const bf16* GV = (const bf16*)(P.ws + WS_GV); const bf16* U = (const bf16*)(P.ws + WS_U); const float* LNS = (const float*)(P.ws + WS_LNSTAT);
    bf16* Y = (bf16*)((unsigned char*)P.out + OUT_Y);
    __syncthreads();
    if (F.tid < 128) { const float* p = LNS + (size_t)(r0 + F.tid) * 32; float s1 = 0.f, s2 = 0.f;
#pragma unroll
        for (int i = 0; i < 16; ++i) { s1 += p[2 * i]; s2 += p[2 * i + 1]; }
        const float mu = s1 * (1.f / GMW), var = fmaxf(s2 * (1.f / GMW) - mu * mu, 0.f); SM[S_STAT + 2 * F.tid] = mu; SM[S_STAT + 2 * F.tid + 1] = __builtin_amdgcn_rsqf(var + EPS); }
    for (int i = F.tid; i < 128 * 32; i += 512) { const int t = i >> 5, s0 = (i & 31) * 4; const f32x4 w = *(const f32x4*)(P.gm_ws + ((size_t)g * 128 + t) * 128 + s0);
        u32x2 pk; pk.x = cvt_pk_bf16(s0 <= t ? w.x : 0.f, s0 + 1 <= t ? w.y : 0.f); pk.y = cvt_pk_bf16(s0 + 2 <= t ? w.z : 0.f, s0 + 3 <= t ? w.w : 0.f); *(LAS u32x2*)(A + t * P136 + s0) = pk; }
    __syncthreads();
    for (int i = F.tid; i < 64 * 16; i += 512) { const int sp = i & 63, oc = i >> 6, s = 2 * sp;
        float v0[8], v1[8]; { const u32x4 a = *(const u32x4*)(GV + (size_t)(r0 + s) * GMW + c0 + 8 * oc), c = *(const u32x4*)(GV + (size_t)(r0 + s + 1) * GMW + c0 + 8 * oc); unpack8(a, v0); unpack8(c, v1); }
        const float mu0 = SM[S_STAT + 2 * s], rs0 = SM[S_STAT + 2 * s + 1], mu1 = SM[S_STAT + 2 * s + 2], rs1 = SM[S_STAT + 2 * s + 3];
#pragma unroll
        for (int e = 0; e < 8; ++e) { const float gg = P.gm_ln_g[c0 + 8 * oc + e], bb = P.gm_ln_b[c0 + 8 * oc + e];
            *(LAS unsigned*)(Bt + (8 * oc + e) * P136 + s) = cvt_pk_bf16((v0[e] - mu0) * rs0 * gg + bb, (v1[e] - mu1) * rs1 * gg + bb); }
    }
    __syncthreads();
    const int wm = F.wave >> 1, wn = F.wave & 1, fr = F.lane & 15, fq = F.lane >> 4;
    f32x4 acc[2][4]; zero_acc(acc);
    lds_mma_t<2, 4>(acc, A, P136, Bt, P136, 32 * wm, 64 * wn, 128, F.lane);
#pragma unroll
    for (int mi = 0; mi < 2; ++mi) { const int t = 32 * wm + 16 * mi + fr; const float bs = P.gm_bs[g * 128 + t];
#pragma unroll
        for (int ni = 0; ni < 4; ++ni) { const int c = c0 + 64 * wn + 16 * ni + 4 * fq; float uu[4]; { const u32x2 a = *(const u32x2*)(U + (size_t)(r0 + t) * GMW + c); unpack4(a, uu); }
            u32x2 w; w.x = cvt_pk_bf16(uu[0] * (acc[mi][ni][0] + bs), uu[1] * (acc[mi][ni][1] + bs)); w.y = cvt_pk_bf16(uu[2] * (acc[mi][ni][2] + bs), uu[3] * (acc[mi][ni][3] + bs));
            *(u32x2*)(Y + (size_t)(r0 + t) * DM + c) = w; } }
    __syncthreads();
}

DI void p3_item(const Frame& F, const Ptrs& P, int item) {
    const int b = item / (MLH * NCH), h = (item / NCH) % MLH, n = item % NCH, r0 = b * SEQ + n * MLC, ch0 = h * MLD;
    LAS bf16* R1 = (LAS bf16*)(F.lds + R1_OFF); LAS bf16* R2 = (LAS bf16*)(F.lds + R2_OFF); LAS float* SM = (LAS float*)(F.lds + SM_OFF);
    const bf16* Q = (const bf16*)(P.ws + WS_Q); const bf16* Kb = (const bf16*)(P.ws + WS_K); const bf16* MVb = (const bf16*)(P.ws + WS_MV);
    bf16* KVT = (bf16*)((unsigned char*)P.out + OUT_KVT) + (size_t)item * MLD * MLD; bf16* INTRA = (bf16*)(P.ws + WS_INTRA);
    float* KSUM = (float*)(P.ws + WS_KSUM) + (size_t)item * MLD; float* DENI = (float*)(P.ws + WS_DENI);
    __syncthreads();
    load_tile256(R1, Q + (size_t)r0 * MLW + ch0, MLW, 128, F.tid);
    load_tile256(R2, Kb + (size_t)r0 * MLW + ch0, MLW, 128, F.tid);
    gates_setup(F, P, SM, b, h, n, n);
    gates_rows(F, SM, n);
    int lane_o = F.lane; asm volatile("" : "+v"(lane_o));
    const int fr = lane_o & 15, fq = lane_o >> 4;
    f32x4 sw[2][4];
    {
        const int wm = F.wave >> 1, wn = F.wave & 1; zero_acc(sw);
        lds_mma_t<2, 4>(sw, R1, P264, R2, P264, 32 * wm, 64 * wn, MLD, lane_o);
#pragma unroll
        for (int mi = 0; mi < 2; ++mi) { const int t = 32 * wm + 16 * mi + fr; const float rt = SM[S_ROWT + t]; float rsum = 0.f;
#pragma unroll
            for (int ni = 0; ni < 4; ++ni) { const int s0 = 64 * wn + 16 * ni + 4 * fq; const f32x4 ct = *(const LAS f32x4*)(SM + S_COLT + s0);
#pragma unroll
                for (int j = 0; j < 4; ++j) { const float arg = (s0 + j <= t) ? rt + ct[j] : -INFINITY; sw[mi][ni][j] *= fexp(arg); rsum += sw[mi][ni][j]; } }
            rsum += __shfl_xor(rsum, 16); rsum += __shfl_xor(rsum, 32);
            if (fq == 0) SM[S_STAT + 2 * t + wn] = rsum; }
    }
    __syncthreads();
#pragma unroll 1
    for (int i = F.tid; i < 64 * 32; i += 512) { const int lp = i & 63, oc = i >> 6, l = 2 * lp; float k0[8], k1[8];
        { const u32x4 a = *(const LAS u32x4*)(R2 + l * P264 + 8 * oc), c = *(const LAS u32x4*)(R2 + (l + 1) * P264 + 8 * oc); unpack8(a, k0); unpack8(c, k1); }
        const float w0 = SM[S_WA + l], w1 = SM[S_WA + l + 1];
#pragma unroll
        for (int e = 0; e < 8; ++e) *(LAS unsigned*)(R1 + (8 * oc + e) * P136 + l) = cvt_pk_bf16(k0[e] * w0, k1[e] * w1); }
    __syncthreads();
    if (F.tid < 256) { float s = 0.f;
#pragma unroll
        for (int c = 0; c < 16; ++c) { float f[8]; const u32x4 a = *(const LAS u32x4*)(R1 + F.tid * P136 + 8 * c); unpack8(a, f);
#pragma unroll
            for (int e = 0; e < 8; ++e) s += f[e]; }
        KSUM[F.tid] = s; }
    if (F.tid < 128) DENI[(size_t)(r0 + F.tid) * 4 + h] = SM[S_STAT + 2 * F.tid] + SM[S_STAT + 2 * F.tid + 1];
#pragma unroll 1
    for (int i = F.tid; i < 64 * 32; i += 512) { const int lp = i & 63, oc = i >> 6, l = 2 * lp; float v0[8], v1[8];
        { const u32x4 a = *(const u32x4*)(MVb + (size_t)(r0 + l) * MLW + ch0 + 8 * oc), c = *(const u32x4*)(MVb + (size_t)(r0 + l + 1) * MLW + ch0 + 8 * oc); unpack8(a, v0); unpack8(c, v1); }
#pragma unroll
        for (int e = 0; e < 8; ++e) *(LAS unsigned*)(R2 + (8 * oc + e) * P136 + l) = cvt_pk_bf16(v0[e], v1[e]); }
    __syncthreads();
    {
        const int wm = F.wave >> 1, wn = F.wave & 1;
#pragma unroll 1
        for (int dh = 0; dh < 2; ++dh) { f32x4 acc[4][4]; zero_acc(acc);
            lds_mma_t<4, 4>(acc, R2, P136, R1, P136, 64 * wm, dh * 128 + 64 * wn, 128, F.lane);
#pragma unroll
            for (int mi = 0; mi < 4; ++mi)
#pragma unroll
                for (int ni = 0; ni < 4; ++ni) { const int e = 64 * wm + 16 * mi + fr, d = dh * 128 + 64 * wn + 16 * ni + 4 * fq;
                    u32x2 w; w.x = cvt_pk_bf16(acc[mi][ni][0], acc[mi][ni][1]); w.y = cvt_pk_bf16(acc[mi][ni][2], acc[mi][ni][3]); *(u32x2*)(KVT + (size_t)e * MLD + d) = w; } }
    }
    __syncthreads();
    {
        const int wm = F.wave >> 1, wn = F.wave & 1;
#pragma unroll
        for (int mi = 0; mi < 2; ++mi)
#pragma unroll
            for (int ni = 0; ni < 4; ++ni) { const int t = 32 * wm + 16 * mi + fr, s = 64 * wn + 16 * ni + 4 * fq;
                u32x2 w; w.x = cvt_pk_bf16(sw[mi][ni][0], sw[mi][ni][1]); w.y = cvt_pk_bf16(sw[mi][ni][2], sw[mi][ni][3]); *(LAS u32x2*)(R1 + t * P136 + s) = w; }
    }
    __syncthreads();
    {
        const int wm = F.wave >> 2, wn = F.wave & 3; f32x4 acc[4][4]; zero_acc(acc);
        lds_mma_t<4, 4>(acc, R1, P136, R2, P136, 64 * wm, 64 * wn, 128, F.lane);
#pragma unroll
        for (int mi = 0; mi < 4; ++mi)
#pragma unroll
            for (int ni = 0; ni < 4; ++ni) { const int t = 64 * wm + 16 * mi + fr, e = 64 * wn + 16 * ni + 4 * fq;
                u32x2 w; w.x = cvt_pk_bf16(acc[mi][ni][0], acc[mi][ni][1]); w.y = cvt_pk_bf16(acc[mi][ni][2], acc[mi][ni][3]); *(u32x2*)(INTRA + (size_t)(r0 + t) * MLW + ch0 + e) = w; }
    }
    __syncthreads();
}

DI void p4_scan_unit(const Frame& F, const Ptrs& P, int unit) {
    const int bh = unit >> 5, seg = unit & 31, b = bh / MLH, h = bh % MLH;
    LAS float* SM = (LAS float*)(F.lds + SM_OFF);
    __syncthreads();
    gates_setup(F, P, SM, b, h, NCH - 1, -1);
    const bf16* KVT = (const bf16*)((unsigned char*)P.out + OUT_KVT) + (size_t)bh * NCH * MLD * MLD + seg * 2048 + F.tid * 4;
    bf16* CT = (bf16*)(P.ws + WS_CT) + (size_t)bh * NCH * MLD * MLD + seg * 2048 + F.tid * 4;
    float c[4] = {0.f, 0.f, 0.f, 0.f};
#pragma unroll 4
    for (int n = 0; n < NCH; ++n) {
        u32x2 o; o.x = cvt_pk_bf16(c[0], c[1]); o.y = cvt_pk_bf16(c[2], c[3]); *(u32x2*)(CT + (size_t)n * MLD * MLD) = o;
        if (n < NCH - 1) { float kv[4]; const u32x2 a = *(const u32x2*)(KVT + (size_t)n * MLD * MLD); unpack4(a, kv); const float dc = SM[S_DECAY + n], sc = SM[S_SCALE + n];
#pragma unroll
            for (int e = 0; e < 4; ++e) c[e] = dc * c[e] + sc * kv[e]; }
    }
    if (seg == 0 && F.tid < 256) { const float* KSUM = (const float*)(P.ws + WS_KSUM) + (size_t)bh * NCH * MLD + F.tid; float* NP = (float*)(P.ws + WS_NPREV) + (size_t)bh * NCH * MLD + F.tid; float nn = 0.f;
        for (int n = 0; n < NCH; ++n) { NP[(size_t)n * MLD] = nn; nn = SM[S_DECAY + n] * nn + SM[S_SCALE + n] * KSUM[(size_t)n * MLD]; } }
    __syncthreads();
}

DI void p5_item(const Frame& F, const Ptrs& P, int item) {
    const int b = item / (MLH * NCH), h = (item / NCH) % MLH, n = item % NCH, r0 = b * SEQ + n * MLC, ch0 = h * MLD;
    LAS bf16* R1 = (LAS bf16*)(F.lds + R1_OFF); LAS bf16* R2 = (LAS bf16*)(F.lds + R2_OFF); LAS float* SM = (LAS float*)(F.lds + SM_OFF);
    const bf16* Q = (const bf16*)(P.ws + WS_Q); const bf16* CT = (const bf16*)(P.ws + WS_CT) + (size_t)item * MLD * MLD; const bf16* INTRA = (const bf16*)(P.ws + WS_INTRA);
    const bf16* MOb = (const bf16*)(P.ws + WS_MO); const float* NP = (const float*)(P.ws + WS_NPREV) + (size_t)item * MLD; const float* DENI = (const float*)(P.ws + WS_DENI);
    bf16* Y = (bf16*)((unsigned char*)P.out + OUT_Y);
    __syncthreads();
    load_tile256(R1, Q + (size_t)r0 * MLW + ch0, MLW, 128, F.tid);
    if (F.tid < 256) SM[S_NPREV + F.tid] = NP[F.tid];
    gates_setup(F, P, SM, b, h, n, n);
    gates_rows(F, SM, n);
    const int fr = F.lane & 15, fq = F.lane >> 4, wm = F.wave >> 1, wn = F.wave & 1;
    {
        const int t = 16 * F.wave + fr; float s = 0.f;
#pragma unroll
        for (int c = 0; c < 8; ++c) { float f[8]; const u32x4 a = *(const LAS u32x4*)(R1 + t * P264 + 64 * fq + 8 * c); unpack8(a, f);
#pragma unroll
            for (int e = 0; e < 8; ++e) s += f[e] * SM[S_NPREV + 64 * fq + 8 * c + e]; }
        s += __shfl_xor(s, 16); s += __shfl_xor(s, 32);
        if (fq == 0) SM[S_QN + t] = s;
    }
    f32x4 hv[2][2][4];
#pragma unroll
    for (int eh = 0; eh < 2; ++eh) {
        __syncthreads();
        load_tile256(R2, CT + (size_t)eh * 128 * MLD, MLD, 128, F.tid);
        __syncthreads();
        zero_acc(hv[eh]);
        lds_mma_t<2, 4>(hv[eh], R1, P264, R2, P264, 32 * wm, 64 * wn, MLD, F.lane);
    }
    float mean[2], rstd[2];
#pragma unroll
    for (int mi = 0; mi < 2; ++mi) { const int t = 32 * wm + 16 * mi + fr, row = r0 + t; const float wi = SM[S_WINT + t], den = wi * SM[S_QN + t] + DENI[(size_t)row * 4 + h];
        const float inv = frcp(fmaxf(fabsf(den), __expf(-SM[S_MT + t]))); float s = 0.f;
#pragma unroll
        for (int eh = 0; eh < 2; ++eh)
#pragma unroll
            for (int ni = 0; ni < 4; ++ni) { const int e = eh * 128 + 64 * wn + 16 * ni + 4 * fq; float it[4]; { const u32x2 a = *(const u32x2*)(INTRA + (size_t)row * MLW + ch0 + e); unpack4(a, it); }
#pragma unroll
                for (int j = 0; j < 4; ++j) { const float v = (wi * hv[eh][mi][ni][j] + it[j]) * inv; hv[eh][mi][ni][j] = v; s += v; } }
        s += __shfl_xor(s, 16); s += __shfl_xor(s, 32);
        if (fq == 0) SM[S_STAT + 2 * t + wn] = s; }
    __syncthreads();
#pragma unroll
    for (int mi = 0; mi < 2; ++mi) { const int t = 32 * wm + 16 * mi + fr; mean[mi] = (SM[S_STAT + 2 * t] + SM[S_STAT + 2 * t + 1]) * (1.f / MLD); }
    __syncthreads();
#pragma unroll
    for (int mi = 0; mi < 2; ++mi) { const int t = 32 * wm + 16 * mi + fr; float s = 0.f;
#pragma unroll
        for (int eh = 0; eh < 2; ++eh)
#pragma unroll
            for (int ni = 0; ni < 4; ++ni)
#pragma unroll
                for (int j = 0; j < 4; ++j) { const float d = hv[eh][mi][ni][j] - mean[mi]; s += d * d; }
        s += __shfl_xor(s, 16); s += __shfl_xor(s, 32);
        if (fq == 0) SM[S_STAT + 2 * t + wn] = s; }
    __syncthreads();
#pragma unroll
    for (int mi = 0; mi < 2; ++mi) { const int t = 32 * wm + 16 * mi + fr, row = r0 + t; rstd[mi] = __builtin_amdgcn_rsqf((SM[S_STAT + 2 * t] + SM[S_STAT + 2 * t + 1]) * (1.f / MLD) + EPS);
#pragma unroll
        for (int eh = 0; eh < 2; ++eh)
#pragma unroll
            for (int ni = 0; ni < 4; ++ni) { const int e = eh * 128 + 64 * wn + 16 * ni + 4 * fq; float og[4]; { const u32x2 a = *(const u32x2*)(MOb + (size_t)row * MLW + ch0 + e); unpack4(a, og); }
                const f32x4 g = *(const f32x4*)(P.ml_norm_g + ch0 + e); float o[4];
#pragma unroll
                for (int j = 0; j < 4; ++j) o[j] = og[j] * ((hv[eh][mi][ni][j] - mean[mi]) * rstd[mi] * g[j]);
                u32x2 w; w.x = cvt_pk_bf16(o[0], o[1]); w.y = cvt_pk_bf16(o[2], o[3]); *(u32x2*)(Y + (size_t)row * DM + GMW + ch0 + e) = w; } }
    __syncthreads();
}

DI void p10_final(const Frame& F, const Ptrs& P) {
    const int gw = F.vcu * 8 + F.wave, NGW = F.G * 8;
    for (int m = gw; m < M; m += NGW) {
        GAS f32x4* xr = (GAS f32x4*)(P.out + (size_t)m * DM) + F.lane; f32x4 v[8]; float s2 = 0.f;
#pragma unroll
        for (int j = 0; j < 8; ++j) { v[j] = xr[64 * j]; s2 += (v[j].x * v[j].x + v[j].y * v[j].y) + (v[j].z * v[j].z + v[j].w * v[j].w); }
        const float rstd = __builtin_amdgcn_rsqf(wave_sum(s2) * (1.f / DM) + EPS);
#pragma unroll
        for (int j = 0; j < 8; ++j) { const f32x4 g = *(const f32x4*)(P.norm_f_g + 256 * j + 4 * F.lane); xr[64 * j] = v[j] * rstd * g; }
    }
}

constexpr int N_PHASES = 11;
struct Args { Ptrs p; int ph_lo, ph_hi; };
__global__ void __launch_bounds__(512, 2) hybrid_fwd(Args args) {
    extern __shared__ __attribute__((aligned(16))) unsigned char lds[];
    Frame F; F.lds = (LAS unsigned char*)lds; F.tid = threadIdx.x; F.lane = F.tid & 63; F.wave = __builtin_amdgcn_readfirstlane(F.tid >> 6);
    F.G = gridDim.x; { const int bx = blockIdx.x; F.vcu = (F.G % 8 == 0) ? (bx % 8) * (F.G / 8) + bx / 8 : bx; }
    typedef const __attribute__((address_space(4))) unsigned char* KArgP;
    const KArgP ap0 = (KArgP)__builtin_amdgcn_kernarg_segment_ptr(); (void)args;
#define PHASE_ARGS KArgP ap = ap0; asm volatile("" : "+s"(ap)); Ptrs P; __builtin_memcpy(&P, ap, sizeof(Ptrs)); unsigned char* ws = P.ws; (void)ws
    unsigned char* ws0; { PHASE_ARGS; ws0 = ws; }
    volatile LAS unsigned* MISC = (volatile LAS unsigned*)(F.lds + MISC_OFF);
    if (F.tid < 64) MISC[F.tid] = 0u;
    __syncthreads();
    const int lo = args.ph_lo, hi = args.ph_hi;
    XcdBarrier bar; bar.bar = (unsigned*)(ws0 + WS_CTL) + CW_BAR; bar.x = 0; bar.st = nullptr;
    if (hi - lo > 1) bar = xcd_barrier_post((unsigned*)(ws0 + WS_CTL) + CW_BAR, MISC + 8);
#ifndef PHASE_MASK
#define PHASE_MASK 0x7ff
#endif
#define IN(k) (((PHASE_MASK >> (k)) & 1) && lo <= (k) && (k) < hi)
#define SEAM(k) do { if (IN(k) && IN((k) + 1)) xcd_barrier(bar); } while (0)
    using namespace pg8;
    if (IN(0)) { PHASE_ARGS; p0_prologue(F, P); } SEAM(0);
    if (IN(1)) { PHASE_ARGS;
        Gemm g{(const bf16_t*)((unsigned char*)P.out + OUT_XB), (const bf16_t*)(ws + WS_WIN), M, NPROJ, DM}; StaticOrder S; S.init(M, NPROJ, F.G, (int)blockIdx.x);
        EpiProj E{(const float*)(ws + WS_RSTD1), P.b_gate, (bf16_t*)(ws + WS_U), (bf16_t*)(ws + WS_GV), (bf16_t*)(ws + WS_MM), (bf16_t*)(ws + WS_MV), (bf16_t*)(ws + WS_MO), (bf16_t*)(ws + WS_GA), (bf16_t*)(ws + WS_GB), (float*)(ws + WS_LNSTAT)};
        gemm_phase<EpiProj, StaticOrder, true>(F.lds, g, S, E);
    } SEAM(1);
    if (IN(2)) { PHASE_ARGS;
        for (int it = F.vcu; it < BATCH * MLH * NCH; it += F.G) p2_qk_item(F, P, it);
        for (int it = F.vcu; it < BATCH * NCH * GMG; it += F.G) p2_gmlp_item(F, P, it);
    } SEAM(2);
    if (IN(3)) { PHASE_ARGS; for (int it = F.vcu; it < BATCH * MLH * NCH; it += F.G) p3_item(F, P, it); } SEAM(3);
    if (IN(4)) { PHASE_ARGS; for (int u = F.vcu; u < BATCH * MLH * 32; u += F.G) p4_scan_unit(F, P, u); } SEAM(4);
    if (IN(5)) { PHASE_ARGS; for (int it = F.vcu; it < BATCH * MLH * NCH; it += F.G) p5_item(F, P, it); } SEAM(5);
    if (IN(6)) { PHASE_ARGS;
        Gemm g{(const bf16_t*)((unsigned char*)P.out + OUT_Y), (const bf16_t*)(ws + WS_WAB), M, DM, DM}; StaticOrder S; S.init(M, DM, F.G, (int)blockIdx.x);
        EpiMix E{(const bf16_t*)(ws + WS_GA), (const bf16_t*)(ws + WS_GB), (bf16_t*)(ws + WS_MIXED)};
        gemm_phase<EpiMix, StaticOrder, true>(F.lds, g, S, E);
    } SEAM(6);
    if (IN(7)) { PHASE_ARGS;
        Gemm g{(const bf16_t*)(ws + WS_MIXED), (const bf16_t*)(ws + WS_WOUT), M, DM, DM}; StaticOrder S; S.init(M, DM, F.G, (int)blockIdx.x);
        EpiRes E{P.x, P.out, (bf16_t*)(ws + WS_X1B), (float*)(ws + WS_X1SS)};
        gemm_phase<EpiRes, StaticOrder, true>(F.lds, g, S, E);
    } SEAM(7);
    if (IN(8)) { PHASE_ARGS;
        Gemm g{(const bf16_t*)(ws + WS_X1B), (const bf16_t*)(ws + WS_WFF1), M, DFF, DM}; StaticOrder S; S.init(M, DFF, F.G, (int)blockIdx.x);
        EpiFF1 E{(const float*)(ws + WS_X1SS), (bf16_t*)(ws + WS_H)};
        gemm_phase<EpiFF1, StaticOrder, true>(F.lds, g, S, E);
    } SEAM(8);
    if (IN(9)) { PHASE_ARGS;
        Gemm g{(const bf16_t*)(ws + WS_H), (const bf16_t*)(ws + WS_WFF2), M, DM, DFF}; StaticOrder S; S.init(M, DM, F.G, (int)blockIdx.x);
        EpiRes E{P.out, P.out, nullptr, nullptr};
        gemm_phase<EpiRes, StaticOrder, true>(F.lds, g, S, E);
    } SEAM(9);
    if (IN(10)) { PHASE_ARGS; p10_final(F, P); }
#undef IN
#undef SEAM
}


#ifdef DUMP_SRC_WS
__global__ void dump_bf16(const unsigned short* src, float* dst, size_t n) {
    for (size_t i = (size_t)blockIdx.x * blockDim.x + threadIdx.x; i < n; i += (size_t)gridDim.x * blockDim.x) dst[i] = __uint_as_float((unsigned)src[i] << 16);
}
#endif
extern "C" void kernel_launch(void* const* d_in, const int* in_sizes, int n_in, void* d_out, int out_size, void* d_ws, size_t ws_size, hipStream_t stream) {
    static int grid = 0;
    if (grid == 0) {
        if (n_in != 22 || in_sizes[0] != M * DM || out_size != M * DM || ws_size < WS_END) { fprintf(stderr, "kernel_launch: unexpected shapes (n_in %d, in0 %d, out %d, ws %zu < %zu); nothing launched\n", n_in, n_in > 0 ? in_sizes[0] : -1, out_size, ws_size, (size_t)WS_END); grid = -1; return; }
        int dev = 0, cus = 0;
        if (hipGetDevice(&dev) != hipSuccess || hipDeviceGetAttribute(&cus, hipDeviceAttributeMultiprocessorCount, dev) != hipSuccess) { grid = -1; return; }
        if (hipFuncSetAttribute((const void*)hybrid_fwd, hipFuncAttributeMaxDynamicSharedMemorySize, LDS_BYTES) != hipSuccess) { fprintf(stderr, "kernel_launch: hipFuncSetAttribute failed\n"); grid = -1; return; }
        int per_cu = 0; (void)hipOccupancyMaxActiveBlocksPerMultiprocessor(&per_cu, (const void*)hybrid_fwd, 512, LDS_BYTES); (void)hipGetLastError();
        grid = cus;
        if (per_cu < 1) fprintf(stderr, "kernel_launch: occupancy query reports %d blocks per CU\n", per_cu);
    }
    if (grid < 0) return;
    (void)hipMemsetAsync((char*)d_ws + WS_CTL, 0, CTL_ZERO_BYTES, stream);
    Args a{};
    const float** pp = (const float**)&a.p;
    for (int i = 0; i < 22; ++i) pp[i] = (const float*)d_in[i];
    a.p.out = (float*)d_out; a.p.ws = (unsigned char*)d_ws;
    if (MK_N_LAUNCHES == 1) { a.ph_lo = 0; a.ph_hi = N_PHASES; hipLaunchKernelGGL(hybrid_fwd, dim3(grid), dim3(512), LDS_BYTES, stream, a); }
    else { for (int ph = 0; ph < N_PHASES; ++ph) { a.ph_lo = ph; a.ph_hi = ph + 1; hipLaunchKernelGGL(hybrid_fwd, dim3(grid), dim3(512), LDS_BYTES, stream, a); } }
#ifdef DUMP_SRC_WS
    hipLaunchKernelGGL(dump_bf16, dim3(2048), dim3(256), 0, stream, (const unsigned short*)((char*)d_ws + (DUMP_SRC_WS)), (float*)d_out + (DUMP_DST_OFF), (size_t)(DUMP_N));
#ifdef DUMP2_SRC_WS
    hipLaunchKernelGGL(dump_bf16, dim3(2048), dim3(256), 0, stream, (const unsigned short*)((char*)d_ws + (DUMP2_SRC_WS)), (float*)d_out + (DUMP2_DST_OFF), (size_t)(DUMP_N));
#endif
#endif
}
```

```cpp
#include <hip/hip_runtime.h>
#include <cstdio>
#include <cstdint>

#ifndef MK_N_LAUNCHES
#define MK_N_LAUNCHES 1
#endif

#define DI __device__ __forceinline__
#define LAS __attribute__((address_space(3)))
#define GAS __attribute__((address_space(1)))
typedef unsigned short bf16;
typedef short bf16x8 __attribute__((ext_vector_type(8)));
typedef float f32x4 __attribute__((ext_vector_type(4)));
typedef float f32x2 __attribute__((ext_vector_type(2)));
typedef unsigned u32x4 __attribute__((ext_vector_type(4)));
typedef unsigned u32x2 __attribute__((ext_vector_type(2)));
typedef GAS unsigned gu32;

constexpr int BATCH = 2, SEQ = 4096, DM = 2048, M = BATCH * SEQ;
constexpr int GMW = 1024, GMG = 8, GMC = 128;
constexpr int MLH = 4, MLD = 256, MLW = 1024, MLC = 128, NCH = SEQ / MLC;
constexpr int DFF = 8192;
constexpr int NIN_SRC = 9224;
constexpr int NPROJ = 9216;
constexpr float EPS = 1e-6f;

__host__ __device__ __forceinline__ size_t blk(int row, int col, int nrows) { return ((size_t)(col >> 6) * nrows + row) * 64 + (col & 63); }
DI float bf2f(unsigned v) { return __uint_as_float(v << 16); }
typedef __bf16 bf16x2_t __attribute__((ext_vector_type(2)));
DI unsigned cvt_pk_bf16(float lo, float hi) { const f32x2 v = {lo, hi}; const bf16x2_t b = __builtin_convertvector(v, bf16x2_t); return __builtin_bit_cast(unsigned, b); }
DI unsigned cvt_pk_bf16_asm(float lo, float hi) { unsigned r; asm volatile("v_cvt_pk_bf16_f32 %0, %1, %2" : "=v"(r) : "v"(lo), "v"(hi)); return r; }
DI float fexp(float x) { return __builtin_amdgcn_exp2f(x * 1.4426950408889634f); }
DI float frcp(float x) { return __builtin_amdgcn_rcpf(x); }
DI float sigmoidf_(float z) { return frcp(1.0f + fexp(-z)); }
DI float gelu_tanh(float x) { const float u = 0.7978845608028654f * (x + 0.044715f * x * x * x); return x * frcp(1.0f + fexp(-2.0f * u)); }
DI float silu_(float x) { return x * frcp(1.0f + fexp(-x)); }
DI void unpack8(const u32x4 w, float (&f)[8]) {
    f[0] = bf2f(w.x & 0xffffu); f[1] = bf2f(w.x >> 16); f[2] = bf2f(w.y & 0xffffu); f[3] = bf2f(w.y >> 16);
    f[4] = bf2f(w.z & 0xffffu); f[5] = bf2f(w.z >> 16); f[6] = bf2f(w.w & 0xffffu); f[7] = bf2f(w.w >> 16);
}
DI void unpack4(const u32x2 w, float (&f)[4]) { f[0] = bf2f(w.x & 0xffffu); f[1] = bf2f(w.x >> 16); f[2] = bf2f(w.y & 0xffffu); f[3] = bf2f(w.y >> 16); }

namespace pg8 {
#define PG8_LAS __attribute__((address_space(3)))
typedef unsigned short bf16_t;
constexpr int BM = 256, BK = 64, HALF = 128, HTB = HALF * BK * 2, STAGE_BYTES = 8 * HTB, NXCD = 8, WGM = 8;

__host__ __device__ __forceinline__ int lds_byte(int r, int c) { const int st = (r >> 4) * 2 + (c >> 5), rr = r & 15, cc = c & 31, ob = rr * 64 + cc * 2; return st * 1024 + (ob ^ (((ob >> 9) & 1) << 5)); }
__host__ __device__ __forceinline__ void stage_rc(int b, int& R, int& C) { const int st = b / 1024, sb = b % 1024, swz = sb ^ (((sb >> 9) & 1) << 5); R = (st >> 1) * 16 + swz / 64; C = (st & 1) * 32 + (swz % 64) / 2; }
__host__ __device__ __forceinline__ int perm32(int rho) { const int n = rho >> 4, i = rho & 15; return 8 * (i >> 2) + 4 * n + (i & 3); }

struct Unit { int pm, pn; };
struct Gemm { const bf16_t* A; const bf16_t* Bt; int M, N, K; };

struct StaticOrder {
    int nM, nN, nwg, G, c;
    __host__ __device__ void init(int M_, int N_, int G_, int c_) { nM = M_ / BM; nN = N_ / BM; nwg = nM * nN; G = G_; c = c_; }
    __host__ __device__ bool next(int i, Unit& u) const {
        const long L = (long)i * G + c; if (L >= nwg) return false;
        int wgid = (int)L; { const int q = nwg / NXCD, r = nwg % NXCD, xcd = wgid % NXCD, off = wgid / NXCD; wgid = (xcd < r ? xcd * (q + 1) : r * (q + 1) + (xcd - r) * q) + off; }
        const int nig = WGM * nN, gid = wgid / nig, fm = gid * WGM, gsz = (nM - fm) < WGM ? (nM - fm) : WGM;
        u.pm = fm + ((wgid % nig) % gsz); u.pn = (wgid % nig) / gsz; return true;
    }
};

typedef f32x4 Acc[2][2][4][2];

struct EpiProj {
    static constexpr bool PERM = true, HAS_MID = false;
    const float* rstd; const float* bgate; bf16_t *U, *GV, *MMb, *MVb, *MOb, *GA, *GB; float* lnstat;
    DI void mid(Acc&, const Unit&, int, int, int, int) const {}
    DI void operator()(const Acc& acc, const Unit& u, int wr, int wc, int fr, int fq) const {
        const int pn = u.pn; bf16_t* base; int ldc, ct, act; const float* bias = nullptr; bool stats = false;
        if (pn < 4) { base = U; ldc = GMW; ct = pn; act = 1; }
        else if (pn < 8) { base = GV; ldc = GMW; ct = pn - 4; act = 1; stats = true; }
        else if (pn < 12) { base = MMb; ldc = MLW; ct = pn - 8; act = 0; }
        else if (pn < 16) { base = MVb; ldc = MLW; ct = pn - 12; act = 0; }
        else if (pn < 20) { base = MOb; ldc = MLW; ct = pn - 16; act = 2; }
        else if (pn < 28) { base = GA; ldc = DM; ct = pn - 20; act = 2; bias = bgate; }
        else { base = GB; ldc = DM; ct = pn - 28; act = 2; bias = bgate + DM; }
        const int row0 = u.pm * BM + wr * 64 + fr, col0 = ct * BM + wc * 32 + 8 * fq;
        f32x4 bv[2][2];
#pragma unroll
        for (int bj = 0; bj < 2; ++bj)
#pragma unroll
            for (int n = 0; n < 2; ++n) bv[bj][n] = bias ? *(const f32x4*)(bias + col0 + bj * HALF + 4 * n) : (f32x4){0.f, 0.f, 0.f, 0.f};
#pragma unroll
        for (int ai = 0; ai < 2; ++ai)
#pragma unroll
            for (int m = 0; m < 4; ++m) {
                const int row = row0 + ai * HALF + m * 16; const float rs = rstd[row]; bf16_t* rowp = base + (size_t)row * ldc + col0;
                float s1 = 0.f, s2 = 0.f;
#pragma unroll
                for (int bj = 0; bj < 2; ++bj) {
                    f32x4 v0 = acc[ai][bj][m][0] * rs + bv[bj][0], v1 = acc[ai][bj][m][1] * rs + bv[bj][1];
                    if (act == 1) {
#pragma unroll
                        for (int e = 0; e < 4; ++e) { v0[e] = gelu_tanh(v0[e]); v1[e] = gelu_tanh(v1[e]); }
                        if (stats) {
#pragma unroll
                            for (int e = 0; e < 4; ++e) { s1 += v0[e] + v1[e]; s2 += v0[e] * v0[e] + v1[e] * v1[e]; }
                        }
                    } else if (act == 2) {
#pragma unroll
                        for (int e = 0; e < 4; ++e) { v0[e] = sigmoidf_(v0[e]); v1[e] = sigmoidf_(v1[e]); }
                    }
                    u32x4 w; w.x = cvt_pk_bf16_asm(v0[0], v0[1]); w.y = cvt_pk_bf16_asm(v0[2], v0[3]); w.z = cvt_pk_bf16_asm(v1[0], v1[1]); w.w = cvt_pk_bf16_asm(v1[2], v1[3]);
                    *(u32x4*)(rowp + bj * HALF) = w;
                }
                if (stats) {
                    s1 += __shfl_xor(s1, 16); s1 += __shfl_xor(s1, 32); s2 += __shfl_xor(s2, 16); s2 += __shfl_xor(s2, 32);
                    if (fq == 0) *(f32x2*)(lnstat + ((size_t)row * 16 + (pn - 4) * 4 + wc) * 2) = (f32x2){s1, s2};
                }
            }
    }
};

struct EpiMix {
    static constexpr bool PERM = true, HAS_MID = true;
    const bf16_t *GA, *GB; bf16_t* O;
    DI void mid(Acc& acc, const Unit& u, int wr, int wc, int fr, int fq) const {
        int opq = 0; asm volatile("" : "+v"(opq));
        const int row0 = u.pm * BM + wr * 64 + fr + opq, col0 = u.pn * BM + wc * 32 + 8 * fq;
#pragma unroll
        for (int ai = 0; ai < 2; ++ai)
#pragma unroll
            for (int m = 0; m < 4; ++m) {
                const size_t off = (size_t)(row0 + ai * HALF + m * 16) * DM + col0;
#pragma unroll
                for (int bj = 0; bj < 2; ++bj) {
                    const u32x4 a = *(const u32x4*)(GA + off + bj * HALF), b = *(const u32x4*)(GB + off + bj * HALF);
                    float fa[8], fb[8]; unpack8(a, fa); unpack8(b, fb);
#pragma unroll
                    for (int e = 0; e < 4; ++e) { acc[ai][bj][m][0][e] *= fa[e] * frcp(fb[e]); acc[ai][bj][m][1][e] *= fa[4 + e] * frcp(fb[4 + e]); }
                }
            }
    }
    DI void operator()(const Acc& acc, const Unit& u, int wr, int wc, int fr, int fq) const {
        const int row0 = u.pm * BM + wr * 64 + fr, col0 = u.pn * BM + wc * 32 + 8 * fq;
#pragma unroll
        for (int ai = 0; ai < 2; ++ai)
#pragma unroll
            for (int m = 0; m < 4; ++m) {
                const size_t off = (size_t)(row0 + ai * HALF + m * 16) * DM + col0;
#pragma unroll
                for (int bj = 0; bj < 2; ++bj) {
                    const u32x4 b = *(const u32x4*)(GB + off + bj * HALF); float fb[8]; unpack8(b, fb);
                    const f32x4 v0 = acc[ai][bj][m][0], v1 = acc[ai][bj][m][1];
                    u32x4 w; w.x = cvt_pk_bf16_asm(v0[0] * fb[0], v0[1] * fb[1]); w.y = cvt_pk_bf16_asm(v0[2] * fb[2], v0[3] * fb[3]);
                    w.z = cvt_pk_bf16_asm(v1[0] * fb[4], v1[1] * fb[5]); w.w = cvt_pk_bf16_asm(v1[2] * fb[6], v1[3] * fb[7]);
                    *(u32x4*)(O + blk(row0 + ai * HALF + m * 16, col0 + bj * HALF, M)) = w;
                }
            }
    }
};

struct EpiRes {
    static constexpr bool PERM = true, HAS_MID = false;
    const float* xin; float* xo; bf16_t* xb; float* ss;
    DI void mid(Acc&, const Unit&, int, int, int, int) const {}
    DI void operator()(const Acc& acc, const Unit& u, int wr, int wc, int fr, int fq) const {
        const int row0 = u.pm * BM + wr * 64 + fr, col0 = u.pn * BM + wc * 32 + 8 * fq;
#pragma unroll
        for (int ai = 0; ai < 2; ++ai)
#pragma unroll
            for (int m = 0; m < 4; ++m) {
                const int row = row0 + ai * HALF + m * 16; const size_t off = (size_t)row * DM + col0; float s2 = 0.f;
#pragma unroll
                for (int bj = 0; bj < 2; ++bj) {
                    const f32x4 x0 = *(const f32x4*)(xin + off + bj * HALF), x1 = *(const f32x4*)(xin + off + bj * HALF + 4);
                    const f32x4 v0 = acc[ai][bj][m][0] + x0, v1 = acc[ai][bj][m][1] + x1;
                    *(f32x4*)(xo + off + bj * HALF) = v0; *(f32x4*)(xo + off + bj * HALF + 4) = v1;
                    if (xb) { u32x4 w; w.x = cvt_pk_bf16_asm(v0[0], v0[1]); w.y = cvt_pk_bf16_asm(v0[2], v0[3]); w.z = cvt_pk_bf16_asm(v1[0], v1[1]); w.w = cvt_pk_bf16_asm(v1[2], v1[3]); *(u32x4*)(xb + blk(row, col0 + bj * HALF, M)) = w; }
#pragma unroll
                    for (int e = 0; e < 4; ++e) s2 += v0[e] * v0[e] + v1[e] * v1[e];
                }
                if (ss) { s2 += __shfl_xor(s2, 16); s2 += __shfl_xor(s2, 32); if (fq == 0) ss[(size_t)row * 32 + u.pn * 4 + wc] = s2; }
            }
    }
};

struct EpiFF1 {
    static constexpr bool PERM = true, HAS_MID = false;
    const float* ss; bf16_t* H;
    DI void mid(Acc&, const Unit&, int, int, int, int) const {}
    DI void operator()(const Acc& acc, const Unit& u, int wr, int wc, int fr, int fq) const {
        const int row0 = u.pm * BM + wr * 64 + fr, col0 = u.pn * BM + wc * 32 + 8 * fq;
#pragma unroll
        for (int ai = 0; ai < 2; ++ai)
#pragma unroll
            for (int m = 0; m < 4; ++m) {
                const int row = row0 + ai * HALF + m * 16;
                const f32x4 p0 = *(const f32x4*)(ss + (size_t)row * 32 + 8 * fq), p1 = *(const f32x4*)(ss + (size_t)row * 32 + 8 * fq + 4);
                float s = ((p0[0] + p0[1]) + (p0[2] + p0[3])) + ((p1[0] + p1[1]) + (p1[2] + p1[3]));
                s += __shfl_xor(s, 16); s += __shfl_xor(s, 32);
                const float rs = __builtin_amdgcn_rsqf(s * (1.0f / DM) + EPS);

#pragma unroll
                for (int bj = 0; bj < 2; ++bj) {
                    f32x4 v0 = acc[ai][bj][m][0] * rs, v1 = acc[ai][bj][m][1] * rs;
#pragma unroll
                    for (int e = 0; e < 4; ++e) { const float a = fmaxf(v0[e], 0.f), b = fmaxf(v1[e], 0.f); v0[e] = a * a; v1[e] = b * b; }
                    u32x4 w; w.x = cvt_pk_bf16_asm(v0[0], v0[1]); w.y = cvt_pk_bf16_asm(v0[2], v0[3]); w.z = cvt_pk_bf16_asm(v1[0], v1[1]); w.w = cvt_pk_bf16_asm(v1[2], v1[3]);
                    *(u32x4*)(H + blk(row, col0 + bj * HALF, M)) = w;
                }
            }
    }
};

template <class Epi, class Sched, bool ALIGN_EPI>
DI void gemm_phase(PG8_LAS unsigned char* lds, const Gemm g, const Sched& S, const Epi& E) {
    const int tid = threadIdx.x, wid = __builtin_amdgcn_readfirstlane(tid >> 6), lane = tid & 63, wr = wid >> 2, wc = wid & 3, fr = lane & 15, fq = lane >> 4;
    const int K = g.K, nt = K / BK;
    unsigned voffA[2], voffB[2];
#pragma unroll
    for (int i = 0; i < 2; ++i) { int R, C; stage_rc(tid * 16 + i * 8192, R, C); const int Rb = Epi::PERM ? ((R & ~31) + perm32(R & 31)) : R;
        voffA[i] = (unsigned)(R * BK + C) * 2u; voffB[i] = (unsigned)(Rb * BK + C) * 2u; }
    const size_t kstepA = (size_t)g.M * BK * 2, kstepB = (size_t)g.N * BK * 2;
    const size_t hstep = (size_t)HALF * BK * 2;
    const size_t tstep = 2 * hstep;
    const unsigned ldsw = (unsigned)wid * 1024u;
    const int aoff = lds_byte(wr * 64 + fr, fq * 8), boff = lds_byte(wc * 32 + fr, fq * 8);
#define PG8_SA(b, h) (((b) * 2 + (h)) * HTB)
#define PG8_SB(b, h) ((4 + (b) * 2 + (h)) * HTB)
#define PG8_STAGE(bufoff, gbase, voff) do { _Pragma("unroll") for (int _i = 0; _i < 2; ++_i) \
        __builtin_amdgcn_global_load_lds((const unsigned*)((const char*)(gbase) + (voff)[_i]), (PG8_LAS unsigned*)(lds + (bufoff) + ldsw + _i * 8192), 16, 0, 0); } while (0)
#define PG8_LDA(dst, b, h) do { _Pragma("unroll") for (int m = 0; m < 4; ++m) _Pragma("unroll") for (int k = 0; k < 2; ++k) dst[m][k] = *(const PG8_LAS bf16x8*)(lds + PG8_SA(b, h) + aoff + m * 2048 + k * 1024); } while (0)
#define PG8_LDB(dst, b, h) do { _Pragma("unroll") for (int n = 0; n < 2; ++n) _Pragma("unroll") for (int k = 0; k < 2; ++k) dst[n][k] = *(const PG8_LAS bf16x8*)(lds + PG8_SB(b, h) + boff + n * 2048 + k * 1024); } while (0)
#define PG8_MMA(ai, bj, At, Bt) do { __builtin_amdgcn_s_setprio(1); _Pragma("unroll") for (int m = 0; m < 4; ++m) _Pragma("unroll") for (int n = 0; n < 2; ++n) _Pragma("unroll") for (int k = 0; k < 2; ++k) \
        acc[ai][bj][m][n] = __builtin_amdgcn_mfma_f32_16x16x32_bf16(Bt[n][k], At[m][k], acc[ai][bj][m][n], 0, 0, 0); __builtin_amdgcn_s_setprio(0); } while (0)
#define PG8_WAIT_V(n) asm volatile("s_waitcnt vmcnt(" #n ")" ::: "memory")
#define PG8_WAIT_L(n) asm volatile("s_waitcnt lgkmcnt(" #n ")" ::: "memory")
#define PG8_BAR __builtin_amdgcn_s_barrier()
#define PG8_SCHED __builtin_amdgcn_sched_barrier(0)
    Unit cur, nxt; int ui = 0;
    if (!S.next(0, cur)) return;
    Acc acc;
#pragma unroll
    for (int a = 0; a < 2; ++a)
#pragma unroll
        for (int b = 0; b < 2; ++b)
#pragma unroll
            for (int m = 0; m < 4; ++m)
#pragma unroll
                for (int n = 0; n < 2; ++n) acc[a][b][m][n] = (f32x4){0.f, 0.f, 0.f, 0.f};
    bf16x8 At[4][2], B0[2][2], B1[2][2];
    const char* cA = (const char*)g.A + (size_t)cur.pm * tstep; const char* cB = (const char*)g.Bt + (size_t)cur.pn * tstep;
    PG8_STAGE(PG8_SB(0, 0), cB, voffB); PG8_STAGE(PG8_SB(0, 1), cB + hstep, voffB); PG8_STAGE(PG8_SA(0, 0), cA, voffA); PG8_STAGE(PG8_SA(0, 1), cA + hstep, voffA);
    if (wr == 1) PG8_BAR;
    PG8_WAIT_V(2); PG8_BAR;
    PG8_STAGE(PG8_SB(1, 0), cB + kstepB, voffB); PG8_STAGE(PG8_SA(1, 0), cA + kstepA, voffA); PG8_STAGE(PG8_SB(1, 1), cB + hstep + kstepB, voffB);
    PG8_WAIT_V(6); PG8_BAR;
    for (;;) {
        const bool has_next = S.next(ui + 1, nxt);
        const char* nA = has_next ? (const char*)g.A + (size_t)nxt.pm * tstep : cA; const char* nB = has_next ? (const char*)g.Bt + (size_t)nxt.pn * tstep : cB;
        for (int t = 0; t < nt; t += 2) {
            const bool last = (t == nt - 2);
            const char* a1 = cA + (size_t)(t + 1) * kstepA;
            const char* a2 = last ? nA : cA + (size_t)(t + 2) * kstepA; const char* b2 = last ? nB : cB + (size_t)(t + 2) * kstepB;
            const char* a3 = a2 + kstepA; const char* b3 = b2 + kstepB;
            if constexpr (Epi::HAS_MID) { if (t == (nt >> 1)) E.mid(acc, cur, wr, wc, fr, fq); }
            PG8_LDB(B0, 0, 0); PG8_LDB(B1, 0, 1); PG8_SCHED; PG8_LDA(At, 0, 0); PG8_STAGE(PG8_SA(1, 1), a1 + hstep, voffA);
            PG8_WAIT_V(8); PG8_WAIT_L(0); PG8_BAR; PG8_MMA(0, 0, At, B0); PG8_MMA(0, 1, At, B1); PG8_BAR; PG8_SCHED;
            PG8_LDA(At, 0, 1); PG8_STAGE(PG8_SB(0, 0), b2, voffB); PG8_STAGE(PG8_SB(0, 1), b2 + hstep, voffB); PG8_STAGE(PG8_SA(0, 0), a2, voffA);
            PG8_WAIT_V(8); PG8_WAIT_L(0); PG8_BAR; PG8_MMA(1, 0, At, B0); PG8_MMA(1, 1, At, B1); PG8_BAR; PG8_SCHED;
            PG8_LDB(B0, 1, 0); PG8_LDB(B1, 1, 1); PG8_SCHED; PG8_LDA(At, 1, 0); PG8_STAGE(PG8_SA(0, 1), a2 + hstep, voffA);
            PG8_WAIT_V(8); PG8_WAIT_L(0); PG8_BAR; PG8_MMA(0, 0, At, B0); PG8_MMA(0, 1, At, B1); PG8_BAR; PG8_SCHED;
            PG8_LDA(At, 1, 1); PG8_STAGE(PG8_SB(1, 0), b3, voffB); PG8_STAGE(PG8_SB(1, 1), b3 + hstep, voffB); PG8_STAGE(PG8_SA(1, 0), a3, voffA);
            PG8_WAIT_V(8); PG8_WAIT_L(0); PG8_BAR; PG8_MMA(1, 0, At, B0); PG8_MMA(1, 1, At, B1); PG8_BAR; PG8_SCHED;
        }
        if constexpr (ALIGN_EPI) { if (wr == 0) PG8_BAR; }
        E(acc, cur, wr, wc, fr, fq);
        if (!has_next) break;
#pragma unroll
        for (int a = 0; a < 2; ++a)
#pragma unroll
            for (int b = 0; b < 2; ++b)
#pragma unroll
                for (int m = 0; m < 4; ++m)
#pragma unroll
                    for (int n = 0; n < 2; ++n) acc[a][b][m][n] = (f32x4){0.f, 0.f, 0.f, 0.f};
        cur = nxt; cA = nA; cB = nB; ++ui;
        if constexpr (ALIGN_EPI) { if (wr == 1) PG8_BAR; }
    }
    PG8_WAIT_V(0);
    if constexpr (!ALIGN_EPI) { if (wr == 0) PG8_BAR; }
    PG8_BAR;
#undef PG8_SA
#undef PG8_SB
#undef PG8_STAGE
#undef PG8_LDA
#undef PG8_LDB
#undef PG8_MMA
#undef PG8_WAIT_V
#undef PG8_WAIT_L
#undef PG8_BAR
#undef PG8_SCHED
}
}

constexpr size_t MiB = 1u << 20;
constexpr size_t WS_CTL = 0, CTL_ZERO_BYTES = 64 * 1024;
constexpr size_t WS_RSTD1 = 1 * MiB;
constexpr size_t WS_GATES = 1 * MiB + 64 * 1024;
constexpr size_t WS_LNSTAT = 2 * MiB;
constexpr size_t WS_X1SS = 3 * MiB;
constexpr size_t WS_KSUM = 4 * MiB;
constexpr size_t WS_NPREV = 4 * MiB + 256 * 1024;
constexpr size_t WS_DENI = 4 * MiB + 512 * 1024;
constexpr size_t WS_WQT = 8 * MiB, WS_WKT = 8 * MiB + 512 * 1024;
constexpr size_t WS_WAB = 9 * MiB;
constexpr size_t WS_WOUT = 17 * MiB;
constexpr size_t WS_WFF1 = 25 * MiB;
constexpr size_t WS_WFF2 = 57 * MiB;
constexpr size_t WS_A = 89 * MiB;
constexpr size_t WS_WIN = WS_A, WS_Q = WS_A, WS_K = WS_A + 16 * MiB, WS_MIXED = WS_A;
constexpr size_t WS_C = 125 * MiB;
constexpr size_t WS_U = WS_C, WS_GV = WS_C + 16 * MiB, WS_MM = WS_C + 32 * MiB, WS_MV = WS_C + 48 * MiB, WS_MO = WS_C + 64 * MiB;
constexpr size_t WS_CT = WS_U;
constexpr size_t WS_INTRA = WS_MM;
constexpr size_t WS_D = 205 * MiB;
constexpr size_t WS_GA = WS_D, WS_GB = WS_D + 32 * MiB;
constexpr size_t WS_X1B = WS_D + 32 * MiB;
constexpr size_t WS_H = WS_A;
constexpr size_t WS_END = 269 * MiB;
static_assert(WS_H + (size_t)M * DFF * 2 <= WS_X1B, "h overlay must not reach X1B");
constexpr size_t OUT_Y = 0, OUT_XB = 32 * MiB, OUT_KVT = 32 * MiB;

constexpr int CW_TMO = 0, CW_BAR = 1024;

constexpr int R1_OFF = 0, R2_OFF = 69632, SM_OFF = 139264, MISC_OFF = 147456, LDS_BYTES = 149504;
constexpr int P264 = 264, P136 = 136;
static_assert(128 * 264 * 2 <= R2_OFF - R1_OFF && 256 * 136 * 2 <= R2_OFF - R1_OFF && 256 * 136 * 2 <= SM_OFF - R2_OFF && SM_OFF + 8192 <= MISC_OFF && MISC_OFF + 256 <= LDS_BYTES && R2_OFF + 8 * 2048 * 4 <= SM_OFF && 8 * 64 * 33 * 4 <= R2_OFF && pg8::STAGE_BYTES <= SM_OFF, "LDS map");
constexpr int S_BCUM = 0, S_IG = 128, S_WA = 256, S_MT = 384, S_WINT = 512, S_COLT = 640, S_ROWT = 768, S_DEN = 896, S_BL = 1024, S_AM = 1056, S_MPREV = 1088, S_DECAY = 1120, S_SCALE = 1152,
              S_QN = 1280, S_NPREV = 1408, S_STAT = 1664;

#define XB_TMO      128
#define XB_XCNT(j)  (256  + 64 * (j))
#define XB_XSUB(j)  (1280 + 64 * (j))
#define XB_XGEN(j)  (2304 + 64 * (j))
#define XB_TOP      3328
#define XB_TOPGEN   3392
#define XCD_BAR_WORDS 3456
#define XB_SPIN_CAP (1u << 20)
DI unsigned xb_ld(unsigned* p)              { return __hip_atomic_load(p, __ATOMIC_RELAXED, __HIP_MEMORY_SCOPE_AGENT); }
DI unsigned xb_add(unsigned* p, unsigned v) { return __hip_atomic_fetch_add(p, v, __ATOMIC_RELAXED, __HIP_MEMORY_SCOPE_AGENT); }
DI unsigned xb_xcc_id() { return (unsigned)__builtin_amdgcn_s_getreg((3 << 11) | 20) & 0xFu; }
#define XB_SPIN(cond, bar) do { unsigned _sp = 0; while (cond) { __builtin_amdgcn_s_sleep(1); \
    if ((++_sp & 255u) == 0u) { if (xb_ld(&(bar)[XB_TMO])) break; if (_sp > XB_SPIN_CAP) { atomicAdd(&(bar)[XB_TMO], 1u); break; } } } } while (0)
struct XcdBarrier { unsigned* bar; unsigned x; volatile LAS unsigned* st; };
DI XcdBarrier xcd_barrier_post(unsigned* bar, volatile LAS unsigned* st) {
    XcdBarrier b; b.bar = bar; b.x = xb_xcc_id(); b.st = st;
    if (threadIdx.x == 0) (void)xb_add(&bar[XB_XCNT(b.x)], 1u);
    return b;
}
DI void xcd_barrier_complete(unsigned* bar, unsigned x, unsigned& nloc, unsigned& nx) {
    const unsigned G = gridDim.x * gridDim.y * gridDim.z;
    unsigned sum, cnt, mine, sp = 0u;
    for (;;) {
        sum = 0u; cnt = 0u; mine = 0u;
#pragma unroll
        for (unsigned j = 0; j < 16; ++j) { const unsigned c = xb_ld(&bar[XB_XCNT(j)]); sum += c; cnt += (c > 0u) ? 1u : 0u; mine = (j == x) ? c : mine; }
        if (sum == G) break;
        __builtin_amdgcn_s_sleep(1);
        if ((++sp & 255u) == 0u) { if (xb_ld(&bar[XB_TMO])) break; if (sp > XB_SPIN_CAP) { atomicAdd(&bar[XB_TMO], 1u); break; } }
    }
    nloc = mine > 0u ? mine : 1u; nx = cnt > 0u ? cnt : 1u;
}
DI void xcd_barrier(const XcdBarrier& b) {
    asm volatile("s_waitcnt vmcnt(0)" ::: "memory");
    __syncthreads();
    if (threadIdx.x == 0) {
        unsigned* bar = b.bar;
        __builtin_amdgcn_s_waitcnt(0);
        unsigned nloc = b.st[0], nx = b.st[1];
        if (nloc == 0u) { xcd_barrier_complete(bar, b.x, nloc, nx); b.st[0] = nloc; b.st[1] = nx; }
        const unsigned old = xb_add(&bar[XB_XSUB(b.x)], 1u);
        const unsigned gen = old / nloc;
        if (old + 1u == (gen + 1u) * nloc) {
            __builtin_amdgcn_fence(__ATOMIC_RELEASE, "agent");
            asm volatile("s_waitcnt vmcnt(0)" ::: "memory");
            const unsigned og = xb_add(&bar[XB_TOP], 1u);
            const unsigned tg = og / nx;
            if (og + 1u == (tg + 1u) * nx) xb_add(&bar[XB_TOPGEN], 1u);
            else XB_SPIN(xb_ld(&bar[XB_TOPGEN]) == tg, bar);
            __builtin_amdgcn_fence(__ATOMIC_ACQUIRE, "agent");
            xb_add(&bar[XB_XGEN(b.x)], 1u);
            asm volatile("s_waitcnt vmcnt(0)" ::: "memory");
        } else {
            XB_SPIN(xb_ld(&bar[XB_XGEN(b.x)]) == gen, bar);
            __builtin_amdgcn_fence(__ATOMIC_ACQUIRE, "agent");
            asm volatile("s_waitcnt vmcnt(0)" ::: "memory");
        }
    }
    __syncthreads();
}

struct Ptrs {
    const float *x, *norm1_g, *w_in, *b_gate, *gm_ln_g, *gm_ln_b, *gm_ws, *gm_bs, *conv_w, *conv_b, *wq, *wk, *ig_b, *fg_b, *ml_norm_g, *w_a, *w_b, *w_out, *norm2_g, *w_ff1, *w_ff2, *norm_f_g;
    float* out; unsigned char* ws;
};
struct Frame { LAS unsigned char* lds; int tid, lane, wave, vcu, G; };
DI float wave_sum(float v) {
#pragma unroll
    for (int o = 1; o < 64; o <<= 1) v += __shfl_xor(v, o);
    return v;
}
DI float wave_max(float v) {
#pragma unroll
    for (int o = 1; o < 64; o <<= 1) v = fmaxf(v, __shfl_xor(v, o));
    return v;
}
#define LDS_WAIT() asm volatile("s_waitcnt lgkmcnt(0)" ::: "memory")

DI void p0_tr64(const float* W, int ldw, int k0, int c0, bf16* WT, int nrows_t, int ldt, int r0, int kd0, const float* kscale, float mul, LAS unsigned* scr, int lane) {
    const int n4 = lane & 15, kq = lane >> 4;
    f32x4 va[8], vb[8];
#pragma unroll
    for (int i = 0; i < 8; ++i) { const int kp = kq + 4 * i; const float* p = W + (size_t)(k0 + 2 * kp) * ldw + c0 + 4 * n4; va[i] = *(const f32x4*)p; vb[i] = *(const f32x4*)(p + ldw); }
#pragma unroll
    for (int i = 0; i < 8; ++i) { const int kp = kq + 4 * i; const float s0 = kscale ? kscale[k0 + 2 * kp] * mul : mul, s1 = kscale ? kscale[k0 + 2 * kp + 1] * mul : mul;
        u32x2 w0, w1; w0.x = cvt_pk_bf16_asm(va[i].x * s0, vb[i].x * s1); w0.y = cvt_pk_bf16_asm(va[i].y * s0, vb[i].y * s1); w1.x = cvt_pk_bf16_asm(va[i].z * s0, vb[i].z * s1); w1.y = cvt_pk_bf16_asm(va[i].w * s0, vb[i].w * s1);
        *(LAS u32x2*)(scr + kp * 66 + 4 * n4) = w0; *(LAS u32x2*)(scr + kp * 66 + 4 * n4 + 2) = w1; }
    LDS_WAIT(); asm volatile("" ::: "memory");
    const int c = lane & 7, nq = lane >> 3;
#pragma unroll
    for (int i = 0; i < 8; ++i) { const int n = nq + 8 * i; u32x4 o; o.x = scr[(4 * c + 0) * 66 + n]; o.y = scr[(4 * c + 1) * 66 + n]; o.z = scr[(4 * c + 2) * 66 + n]; o.w = scr[(4 * c + 3) * 66 + n];
        bf16* dst = nrows_t ? WT + ((size_t)((kd0 + k0) >> 6) * nrows_t + r0 + n) * 64 + 8 * c : WT + (size_t)(r0 + n) * ldt + kd0 + k0 + 8 * c;
        *(GAS u32x4*)dst = o; }
    LDS_WAIT(); asm volatile("" ::: "memory");
}
DI void p0_prologue(const Frame& F, const Ptrs& P) {
    LAS unsigned* scr = (LAS unsigned*)(F.lds) + F.wave * (32 * 66);
    LAS float* WG = (LAS float*)(F.lds + R2_OFF);
    unsigned char* ws = P.ws;
    for (int i = F.tid; i < DM * 8; i += 512) { const int k = i >> 3, j = i & 7; WG[j * DM + k] = P.w_in[(size_t)k * NIN_SRC + 5120 + j] * P.norm1_g[k]; }
    __syncthreads();
    const int gw = F.vcu * 8 + F.wave, NGW = F.G * 8;
    {
        bf16* XB = (bf16*)((unsigned char*)P.out + OUT_XB); float* RSTD = (float*)(ws + WS_RSTD1); float* GATES = (float*)(ws + WS_GATES);
        for (int m = gw; m < M; m += NGW) {
            const GAS f32x4* xr = (const GAS f32x4*)(P.x + (size_t)m * DM) + F.lane;
            f32x4 v[8]; float s2 = 0.f;
#pragma unroll
            for (int j = 0; j < 8; ++j) { v[j] = xr[64 * j]; s2 += (v[j].x * v[j].x + v[j].y * v[j].y) + (v[j].z * v[j].z + v[j].w * v[j].w); }
            const float rstd = __builtin_amdgcn_rsqf(wave_sum(s2) * (1.f / DM) + EPS);
#pragma unroll
            for (int j = 0; j < 8; ++j) { u32x2 w; w.x = cvt_pk_bf16_asm(v[j].x, v[j].y); w.y = cvt_pk_bf16_asm(v[j].z, v[j].w); *(GAS u32x2*)(XB + blk(m, 256 * j + 4 * F.lane, M)) = w; }
            float gsum[8];
#pragma unroll
            for (int g = 0; g < 8; ++g) { float a = 0.f;
#pragma unroll
                for (int j = 0; j < 8; ++j) { const f32x4 w = *(const LAS f32x4*)(WG + g * DM + 256 * j + 4 * F.lane); a += (v[j].x * w.x + v[j].y * w.y) + (v[j].z * w.z + v[j].w * w.w); }
                gsum[g] = wave_sum(a) * rstd; }
            if (F.lane == 0) { RSTD[m] = rstd; *(GAS f32x4*)(GATES + (size_t)m * 8) = (f32x4){gsum[0], gsum[1], gsum[2], gsum[3]}; *(GAS f32x4*)(GATES + (size_t)m * 8 + 4) = (f32x4){gsum[4], gsum[5], gsum[6], gsum[7]}; }
        }
    }
    int base = 0;
#define P0_JOB(W_, ldw_, K_, ncols_, c0_, WT_, nrt_, r0_, kd0_, ks_) do { const int nblk = (ncols_) / 64, items = ((K_) / 64) * nblk; \
        int first = gw - (base % NGW); if (first < 0) first += NGW; \
        for (int it = first; it < items; it += NGW) { const int kb = it / nblk, nb = it % nblk; \
            p0_tr64((W_), (ldw_), 64 * kb, (c0_) + 64 * nb, (WT_), (nrt_), 0, (r0_) + 64 * nb, (kd0_), (ks_), 1.f, scr, F.lane); } \
        base += items; } while (0)
    P0_JOB(P.w_in, NIN_SRC, DM, 5120, 0, (bf16*)(ws + WS_WIN), NPROJ, 0, 0, P.norm1_g);
    P0_JOB(P.w_in, NIN_SRC, DM, 4096, 5128, (bf16*)(ws + WS_WIN), NPROJ, 5120, 0, P.norm1_g);
    P0_JOB(P.w_a, DM, GMW, DM, 0, (bf16*)(ws + WS_WAB), DM, 0, 0, (const float*)nullptr);
    P0_JOB(P.w_b, DM, MLW, DM, 0, (bf16*)(ws + WS_WAB), DM, 0, GMW, (const float*)nullptr);
    P0_JOB(P.w_out, DM, DM, DM, 0, (bf16*)(ws + WS_WOUT), DM, 0, 0, (const float*)nullptr);
    P0_JOB(P.w_ff1, DFF, DM, DFF, 0, (bf16*)(ws + WS_WFF1), DFF, 0, 0, P.norm2_g);
    P0_JOB(P.w_ff2, DM, DFF, DM, 0, (bf16*)(ws + WS_WFF2), DM, 0, 0, (const float*)nullptr);
#undef P0_JOB
    for (int it = gw; it < 2 * MLH * 16; it += NGW) {
        const int mat = it / (MLH * 16), r = it % (MLH * 16), h = r / 16, kb = (r % 16) / 4, nb = r % 4;
        const float* W = (mat ? P.wk : P.wq) + (size_t)h * MLD * MLD; bf16* WT = (bf16*)(ws + (mat ? WS_WKT : WS_WQT)) + (size_t)h * MLD * MLD;
        p0_tr64(W, MLD, 64 * kb, 64 * nb, WT, 0, MLD, 64 * nb, 0, nullptr, mat ? 0.0625f : 1.f, scr, F.lane);
    }
}

template <int MT, int NT>
DI void lds_mma_t(f32x4 (&acc)[MT][NT], const LAS bf16* A, int pa, const LAS bf16* Bt, int pb, int m0, int n0, int K, int lane) {
    const int fr = lane & 15, fq = lane >> 4;
    const LAS bf16* ap = A + (m0 + fr) * pa + 8 * fq; const LAS bf16* bp = Bt + (n0 + fr) * pb + 8 * fq;
    for (int k0 = 0; k0 < K; k0 += 32) {
        bf16x8 a[MT], b[NT];
#pragma unroll
        for (int mi = 0; mi < MT; ++mi) a[mi] = *(const LAS bf16x8*)(ap + mi * 16 * pa + k0);
#pragma unroll
        for (int ni = 0; ni < NT; ++ni) b[ni] = *(const LAS bf16x8*)(bp + ni * 16 * pb + k0);
#pragma unroll
        for (int mi = 0; mi < MT; ++mi)
#pragma unroll
            for (int ni = 0; ni < NT; ++ni) acc[mi][ni] = __builtin_amdgcn_mfma_f32_16x16x32_bf16(b[ni], a[mi], acc[mi][ni], 0, 0, 0);
    }
}
template <int MT, int NT> DI void zero_acc(f32x4 (&acc)[MT][NT]) {
#pragma unroll
    for (int a = 0; a < MT; ++a)
#pragma unroll
        for (int b = 0; b < NT; ++b) acc[a][b] = (f32x4){0.f, 0.f, 0.f, 0.f};
}
DI void load_tile256(LAS bf16* dst, const bf16* src, int ldg, int rows, int tid) {
    for (int i = tid; i < rows * 32; i += 512) { const int r = i >> 5, c = i & 31; *(LAS u32x4*)(dst + r * P264 + 8 * c) = *(const u32x4*)(src + (size_t)r * ldg + 8 * c); }
}

DI void gates_setup(const Frame& F, const Ptrs& P, LAS float* SM, int b, int h, int nlast, int nfull) {
    const float* GATES = (const float*)(P.ws + WS_GATES); const float igb = P.ig_b[h], fgb = P.fg_b[h];
    for (int c = F.wave; c <= nlast; c += 8) {
        const int row = b * SEQ + c * MLC + 2 * F.lane;
        const float i0 = GATES[(size_t)row * 8 + h] + igb, i1 = GATES[(size_t)(row + 1) * 8 + h] + igb;
        const float z0 = GATES[(size_t)row * 8 + 4 + h] + fgb, z1 = GATES[(size_t)(row + 1) * 8 + 4 + h] + fgb;
        const float l0 = fminf(z0, 0.f) - __logf(1.f + __expf(-fabsf(z0))), l1 = fminf(z1, 0.f) - __logf(1.f + __expf(-fabsf(z1)));
        float sc = l0 + l1;
#pragma unroll
        for (int o = 1; o < 64; o <<= 1) { const float t = __shfl_up(sc, o); if (F.lane >= o) sc += t; }
        const float bc1 = sc, bc0 = sc - l1, blast = __shfl(sc, 63);
        const float a0 = blast - bc0 + i0, a1 = blast - bc1 + i1, amax = wave_max(fmaxf(a0, a1));
        if (F.lane == 0) { SM[S_BL + c] = blast; SM[S_AM + c] = amax; }
        if (c == nfull) {
            SM[S_BCUM + 2 * F.lane] = bc0; SM[S_BCUM + 2 * F.lane + 1] = bc1; SM[S_IG + 2 * F.lane] = i0; SM[S_IG + 2 * F.lane + 1] = i1;
            SM[S_WA + 2 * F.lane] = __expf(a0 - amax); SM[S_WA + 2 * F.lane + 1] = __expf(a1 - amax);
            SM[S_COLT + 2 * F.lane] = i0 - bc0; SM[S_COLT + 2 * F.lane + 1] = i1 - bc1;
        }
    }
    __syncthreads();
    if (F.tid == 0) { float m = 0.f;
        for (int c = 0; c <= nlast; ++c) { const float bl = SM[S_BL + c], am = SM[S_AM + c]; SM[S_MPREV + c] = m; const float mn = fmaxf(bl + m, am); SM[S_DECAY + c] = __expf(bl + m - mn); SM[S_SCALE + c] = __expf(am - mn); m = mn; } }
    __syncthreads();
}
DI void gates_rows(const Frame& F, LAS float* SM, int nfull) {
    if (F.wave == 0) {
        const float mp = SM[S_MPREV + nfull];
        const float c0 = SM[S_COLT + 2 * F.lane], c1 = SM[S_COLT + 2 * F.lane + 1];
        float pm = fmaxf(c0, c1);
#pragma unroll
        for (int o = 1; o < 64; o <<= 1) { const float t = __shfl_up(pm, o); if (F.lane >= o) pm = fmaxf(pm, t); }
        float pprev = __shfl_up(pm, 1); if (F.lane == 0) pprev = -INFINITY;
        const float pm0 = fmaxf(pprev, c0), pm1 = pm;
        const float b0 = SM[S_BCUM + 2 * F.lane], b1 = SM[S_BCUM + 2 * F.lane + 1];
        const float mt0 = fmaxf(b0 + mp, b0 + pm0), mt1 = fmaxf(b1 + mp, b1 + pm1);
        SM[S_MT + 2 * F.lane] = mt0; SM[S_MT + 2 * F.lane + 1] = mt1;
        SM[S_WINT + 2 * F.lane] = __expf(b0 + mp - mt0); SM[S_WINT + 2 * F.lane + 1] = __expf(b1 + mp - mt1);
        SM[S_ROWT + 2 * F.lane] = b0 - mt0; SM[S_ROWT + 2 * F.lane + 1] = b1 - mt1;
    }
    __syncthreads();
}

DI void p2_qk_item(const Frame& F, const Ptrs& P, int item) {
    const int b = item / (MLH * NCH), h = (item / NCH) % MLH, n = item % NCH, r0 = b * SEQ + n * MLC, ch0 = h * MLD;
    LAS bf16* R1 = (LAS bf16*)(F.lds + R1_OFF); LAS bf16* R2 = (LAS bf16*)(F.lds + R2_OFF);
    const bf16* MMb = (const bf16*)(P.ws + WS_MM);
    {
        const int oc = F.tid & 31, rg = F.tid >> 5, l0 = rg * 8, ch = ch0 + 8 * oc;
        float w[4][8], cb[8];
#pragma unroll
        for (int j = 0; j < 4; ++j) { const f32x4 a = *(const f32x4*)(P.conv_w + j * MLW + ch), c = *(const f32x4*)(P.conv_w + j * MLW + ch + 4);
            w[j][0] = a.x; w[j][1] = a.y; w[j][2] = a.z; w[j][3] = a.w; w[j][4] = c.x; w[j][5] = c.y; w[j][6] = c.z; w[j][7] = c.w; }
        { const f32x4 a = *(const f32x4*)(P.conv_b + ch), c = *(const f32x4*)(P.conv_b + ch + 4); cb[0] = a.x; cb[1] = a.y; cb[2] = a.z; cb[3] = a.w; cb[4] = c.x; cb[5] = c.y; cb[6] = c.z; cb[7] = c.w; }
        float win[3][8];
#pragma unroll
        for (int i = 0; i < 3; ++i) { const int pos = n * MLC + l0 - 3 + i;
            if (pos >= 0) { const u32x4 v = *(const u32x4*)(MMb + (size_t)(r0 + l0 - 3 + i) * MLW + ch); unpack8(v, win[i]); }
            else {
#pragma unroll
                for (int e = 0; e < 8; ++e) win[i][e] = 0.f; } }
#pragma unroll
        for (int l = 0; l < 8; ++l) {
            float cur[8]; { const u32x4 v = *(const u32x4*)(MMb + (size_t)(r0 + l0 + l) * MLW + ch); unpack8(v, cur); }
            float o[8];
#pragma unroll
            for (int e = 0; e < 8; ++e) o[e] = silu_(cb[e] + w[0][e] * win[0][e] + w[1][e] * win[1][e] + w[2][e] * win[2][e] + w[3][e] * cur[e]);
            u32x4 pk; pk.x = cvt_pk_bf16(o[0], o[1]); pk.y = cvt_pk_bf16(o[2], o[3]); pk.z = cvt_pk_bf16(o[4], o[5]); pk.w = cvt_pk_bf16(o[6], o[7]);
            *(LAS u32x4*)(R1 + (l0 + l) * P264 + 8 * oc) = pk;
#pragma unroll
            for (int e = 0; e < 8; ++e) { win[0][e] = win[1][e]; win[1][e] = win[2][e]; win[2][e] = cur[e]; }
        }
    }
    const int wm = F.wave >> 1, wn = F.wave & 1, fr = F.lane & 15, fq = F.lane >> 4;
#pragma unroll 1
    for (int pass = 0; pass < 4; ++pass) {
        const int mat = pass >> 1, half = pass & 1;
        const bf16* WT = (const bf16*)(P.ws + (mat ? WS_WKT : WS_WQT)) + (size_t)h * MLD * MLD + (size_t)half * 128 * MLD;
        __syncthreads();
        load_tile256(R2, WT, MLD, 128, F.tid);
        __syncthreads();
        f32x4 acc[2][4]; zero_acc(acc);
        lds_mma_t<2, 4>(acc, R1, P264, R2, P264, 32 * wm, 64 * wn, MLD, F.lane);
        bf16* O = (bf16*)(P.ws + (mat ? WS_K : WS_Q));
#pragma unroll
        for (int mi = 0; mi < 2; ++mi)
#pragma unroll
            for (int ni = 0; ni < 4; ++ni) { const int row = r0 + 32 * wm + 16 * mi + fr, col = ch0 + half * 128 + 64 * wn + 16 * ni + 4 * fq;
                u32x2 w; w.x = cvt_pk_bf16(acc[mi][ni][0], acc[mi][ni][1]); w.y = cvt_pk_bf16(acc[mi][ni][2], acc[mi][ni][3]); *(u32x2*)(O + (size_t)row * MLW + col) = w; }
    }
    __syncthreads();
}
DI void p2_gmlp_item(const Frame& F, const Ptrs& P, int item) {
    const int b = item / (NCH * GMG), n = (item / GMG) % NCH, g = item % GMG, r0 = b * SEQ + n * GMC, c0 = g * 128;
    LAS bf16* A = (LAS bf16*)(F.lds + R1_OFF); LAS bf16* Bt = (LAS bf16*)(F.lds + R2_OFF); LAS float* SM = (LAS float*)(F.lds + SM_OFF);
    const bf16* GV = (const bf16*)(P.ws + WS_GV); const bf16* U = (const bf16*)(P.ws + WS_U); const float* LNS = (const float*)(P.ws + WS_LNSTAT);
    bf16* Y = (bf16*)((unsigned char*)P.out + OUT_Y);
    __syncthreads();
    if (F.tid < 128) { const float* p = LNS + (size_t)(r0 + F.tid) * 32; float s1 = 0.f, s2 = 0.f;
#pragma unroll
        for (int i = 0; i < 16; ++i) { s1 += p[2 * i]; s2 += p[2 * i + 1]; }
        const float mu = s1 * (1.f / GMW), var = fmaxf(s2 * (1.f / GMW) - mu * mu, 0.f); SM[S_STAT + 2 * F.tid] = mu; SM[S_STAT + 2 * F.tid + 1] = __builtin_amdgcn_rsqf(var + EPS); }
    for (int i = F.tid; i < 128 * 32; i += 512) { const int t = i >> 5, s0 = (i & 31) * 4; const f32x4 w = *(const f32x4*)(P.gm_ws + ((size_t)g * 128 + t) * 128 + s0);
        u32x2 pk; pk.x = cvt_pk_bf16(s0 <= t ? w.x : 0.f, s0 + 1 <= t ? w.y : 0.f); pk.y = cvt_pk_bf16(s0 + 2 <= t ? w.z : 0.f, s0 + 3 <= t ? w.w : 0.f); *(LAS u32x2*)(A + t * P136 + s0) = pk; }
    __syncthreads();
    for (int i = F.tid; i < 64 * 16; i += 512) { const int sp = i & 63, oc = i >> 6, s = 2 * sp;
        float v0[8], v1[8]; { const u32x4 a = *(const u32x4*)(GV + (size_t)(r0 + s) * GMW + c0 + 8 * oc), c = *(const u32x4*)(GV + (size_t)(r0 + s + 1) * GMW + c0 + 8 * oc); unpack8(a, v0); unpack8(c, v1); }
        const float mu0 = SM[S_STAT + 2 * s], rs0 = SM[S_STAT + 2 * s + 1], mu1 = SM[S_STAT + 2 * s + 2], rs1 = SM[S_STAT + 2 * s + 3];
#pragma unroll
        for (int e = 0; e < 8; ++e) { const float gg = P.gm_ln_g[c0 + 8 * oc + e], bb = P.gm_ln_b[c0 + 8 * oc + e];
            *(LAS unsigned*)(Bt + (8 * oc + e) * P136 + s) = cvt_pk_bf16((v0[e] - mu0) * rs0 * gg + bb, (v1[e] - mu1) * rs1 * gg + bb); }
    }
    __syncthreads();
    const int wm = F.wave >> 1, wn = F.wave & 1, fr = F.lane & 15, fq = F.lane >> 4;
    f32x4 acc[2][4]; zero_acc(acc);
    lds_mma_t<2, 4>(acc, A, P136, Bt, P136, 32 * wm, 64 * wn, 128, F.lane);
#pragma unroll
    for (int mi = 0; mi < 2; ++mi) { const int t = 32 * wm + 16 * mi + fr; const float bs = P.gm_bs[g * 128 + t];
#pragma unroll
        for (int ni = 0; ni < 4; ++ni) { const int c = c0 + 64 * wn + 16 * ni + 4 * fq; float uu[4]; { const u32x2 a = *(const u32x2*)(U + (size_t)(r0 + t) * GMW + c); unpack4(a, uu); }
            u32x2 w; w.x = cvt_pk_bf16(uu[0] * (acc[mi][ni][0] + bs), uu[1] * (acc[mi][ni][1] + bs)); w.y = cvt_pk_bf16(uu[2] * (acc[mi][ni][2] + bs), uu[3] * (acc[mi][ni][3] + bs));
            *(u32x2*)(Y + blk(r0 + t, c, M)) = w; } }
    __syncthreads();
}

DI void p3_item(const Frame& F, const Ptrs& P, int item) {
    const int b = item / (MLH * NCH), h = (item / NCH) % MLH, n = item % NCH, r0 = b * SEQ + n * MLC, ch0 = h * MLD;
    LAS bf16* R1 = (LAS bf16*)(F.lds + R1_OFF); LAS bf16* R2 = (LAS bf16*)(F.lds + R2_OFF); LAS float* SM = (LAS float*)(F.lds + SM_OFF);
    const bf16* Q = (const bf16*)(P.ws + WS_Q); const bf16* Kb = (const bf16*)(P.ws + WS_K); const bf16* MVb = (const bf16*)(P.ws + WS_MV);
    bf16* KVT = (bf16*)((unsigned char*)P.out + OUT_KVT) + (size_t)item * MLD * MLD; bf16* INTRA = (bf16*)(P.ws + WS_INTRA);
    float* KSUM = (float*)(P.ws + WS_KSUM) + (size_t)item * MLD; float* DENI = (float*)(P.ws + WS_DENI);
    __syncthreads();
    load_tile256(R1, Q + (size_t)r0 * MLW + ch0, MLW, 128, F.tid);
    load_tile256(R2, Kb + (size_t)r0 * MLW + ch0, MLW, 128, F.tid);
    gates_setup(F, P, SM, b, h, n, n);
    gates_rows(F, SM, n);
    int lane_o = F.lane; asm volatile("" : "+v"(lane_o));
    const int fr = lane_o & 15, fq = lane_o >> 4;
    f32x4 sw[2][4];
    {
        const int wm = F.wave >> 1, wn = F.wave & 1; zero_acc(sw);
        lds_mma_t<2, 4>(sw, R1, P264, R2, P264, 32 * wm, 64 * wn, MLD, lane_o);
#pragma unroll
        for (int mi = 0; mi < 2; ++mi) { const int t = 32 * wm + 16 * mi + fr; const float rt = SM[S_ROWT + t]; float rsum = 0.f;
#pragma unroll
            for (int ni = 0; ni < 4; ++ni) { const int s0 = 64 * wn + 16 * ni + 4 * fq; const f32x4 ct = *(const LAS f32x4*)(SM + S_COLT + s0);
#pragma unroll
                for (int j = 0; j < 4; ++j) { const float arg = (s0 + j <= t) ? rt + ct[j] : -INFINITY; sw[mi][ni][j] *= fexp(arg); rsum += sw[mi][ni][j]; } }
            rsum += __shfl_xor(rsum, 16); rsum += __shfl_xor(rsum, 32);
            if (fq == 0) SM[S_STAT + 2 * t + wn] = rsum; }
    }
    __syncthreads();
#pragma unroll 1
    for (int i = F.tid; i < 64 * 32; i += 512) { const int lp = i & 63, oc = i >> 6, l = 2 * lp; float k0[8], k1[8];
        { const u32x4 a = *(const LAS u32x4*)(R2 + l * P264 + 8 * oc), c = *(const LAS u32x4*)(R2 + (l + 1) * P264 + 8 * oc); unpack8(a, k0); unpack8(c, k1); }
        const float w0 = SM[S_WA + l], w1 = SM[S_WA + l + 1];
#pragma unroll
        for (int e = 0; e < 8; ++e) *(LAS unsigned*)(R1 + (8 * oc + e) * P136 + l) = cvt_pk_bf16(k0[e] * w0, k1[e] * w1); }
    __syncthreads();
    if (F.tid < 256) { float s = 0.f;
#pragma unroll
        for (int c = 0; c < 16; ++c) { float f[8]; const u32x4 a = *(const LAS u32x4*)(R1 + F.tid * P136 + 8 * c); unpack8(a, f);
#pragma unroll
            for (int e = 0; e < 8; ++e) s += f[e]; }
        KSUM[F.tid] = s; }
    if (F.tid < 128) DENI[(size_t)(r0 + F.tid) * 4 + h] = SM[S_STAT + 2 * F.tid] + SM[S_STAT + 2 * F.tid + 1];
#pragma unroll 1
    for (int i = F.tid; i < 64 * 32; i += 512) { const int lp = i & 63, oc = i >> 6, l = 2 * lp; float v0[8], v1[8];
        { const u32x4 a = *(const u32x4*)(MVb + (size_t)(r0 + l) * MLW + ch0 + 8 * oc), c = *(const u32x4*)(MVb + (size_t)(r0 + l + 1) * MLW + ch0 + 8 * oc); unpack8(a, v0); unpack8(c, v1); }
#pragma unroll
        for (int e = 0; e < 8; ++e) *(LAS unsigned*)(R2 + (8 * oc + e) * P136 + l) = cvt_pk_bf16(v0[e], v1[e]); }
    __syncthreads();
    {
        const int wm = F.wave >> 1, wn = F.wave & 1;
#pragma unroll 1
        for (int dh = 0; dh < 2; ++dh) { f32x4 acc[4][4]; zero_acc(acc);
            lds_mma_t<4, 4>(acc, R2, P136, R1, P136, 64 * wm, dh * 128 + 64 * wn, 128, F.lane);
#pragma unroll
            for (int mi = 0; mi < 4; ++mi)
#pragma unroll
                for (int ni = 0; ni < 4; ++ni) { const int e = 64 * wm + 16 * mi + fr, d = dh * 128 + 64 * wn + 16 * ni + 4 * fq;
                    u32x2 w; w.x = cvt_pk_bf16(acc[mi][ni][0], acc[mi][ni][1]); w.y = cvt_pk_bf16(acc[mi][ni][2], acc[mi][ni][3]); *(u32x2*)(KVT + (size_t)e * MLD + d) = w; } }
    }
    __syncthreads();
    {
        const int wm = F.wave >> 1, wn = F.wave & 1;
#pragma unroll
        for (int mi = 0; mi < 2; ++mi)
#pragma unroll
            for (int ni = 0; ni < 4; ++ni) { const int t = 32 * wm + 16 * mi + fr, s = 64 * wn + 16 * ni + 4 * fq;
                u32x2 w; w.x = cvt_pk_bf16(sw[mi][ni][0], sw[mi][ni][1]); w.y = cvt_pk_bf16(sw[mi][ni][2], sw[mi][ni][3]); *(LAS u32x2*)(R1 + t * P136 + s) = w; }
    }
    __syncthreads();
    {
        const int wm = F.wave >> 2, wn = F.wave & 3; f32x4 acc[4][4]; zero_acc(acc);
        lds_mma_t<4, 4>(acc, R1, P136, R2, P136, 64 * wm, 64 * wn, 128, F.lane);
#pragma unroll
        for (int mi = 0; mi < 4; ++mi)
#pragma unroll
            for (int ni = 0; ni < 4; ++ni) { const int t = 64 * wm + 16 * mi + fr, e = 64 * wn + 16 * ni + 4 * fq;
                u32x2 w; w.x = cvt_pk_bf16(acc[mi][ni][0], acc[mi][ni][1]); w.y = cvt_pk_bf16(acc[mi][ni][2], acc[mi][ni][3]); *(u32x2*)(INTRA + (size_t)(r0 + t) * MLW + ch0 + e) = w; }
    }
    __syncthreads();
}

DI void p4_scan_unit(const Frame& F, const Ptrs& P, int unit) {
    const int bh = unit >> 5, seg = unit & 31, b = bh / MLH, h = bh % MLH;
    LAS float* SM = (LAS float*)(F.lds + SM_OFF);
    __syncthreads();
    gates_setup(F, P, SM, b, h, NCH - 1, -1);
    const bf16* KVT = (const bf16*)((unsigned char*)P.out + OUT_KVT) + (size_t)bh * NCH * MLD * MLD + seg * 2048 + F.tid * 4;
    bf16* CT = (bf16*)(P.ws + WS_CT) + (size_t)bh * NCH * MLD * MLD + seg * 2048 + F.tid * 4;
    float c[4] = {0.f, 0.f, 0.f, 0.f};
#pragma unroll 4
    for (int n = 0; n < NCH; ++n) {
        u32x2 o; o.x = cvt_pk_bf16(c[0], c[1]); o.y = cvt_pk_bf16(c[2], c[3]); *(u32x2*)(CT + (size_t)n * MLD * MLD) = o;
        if (n < NCH - 1) { float kv[4]; const u32x2 a = *(const u32x2*)(KVT + (size_t)n * MLD * MLD); unpack4(a, kv); const float dc = SM[S_DECAY + n], sc = SM[S_SCALE + n];
#pragma unroll
            for (int e = 0; e < 4; ++e) c[e] = dc * c[e] + sc * kv[e]; }
    }
    if (seg == 0 && F.tid < 256) { const float* KSUM = (const float*)(P.ws + WS_KSUM) + (size_t)bh * NCH * MLD + F.tid; float* NP = (float*)(P.ws + WS_NPREV) + (size_t)bh * NCH * MLD + F.tid; float nn = 0.f;
        for (int n = 0; n < NCH; ++n) { NP[(size_t)n * MLD] = nn; nn = SM[S_DECAY + n] * nn + SM[S_SCALE + n] * KSUM[(size_t)n * MLD]; } }
    __syncthreads();
}

DI void p5_item(const Frame& F, const Ptrs& P, int item) {
    const int b = item / (MLH * NCH), h = (item / NCH) % MLH, n = item % NCH, r0 = b * SEQ + n * MLC, ch0 = h * MLD;
    LAS bf16* R1 = (LAS bf16*)(F.lds + R1_OFF); LAS bf16* R2 = (LAS bf16*)(F.lds + R2_OFF); LAS float* SM = (LAS float*)(F.lds + SM_OFF);
    const bf16* Q = (const bf16*)(P.ws + WS_Q); const bf16* CT = (const bf16*)(P.ws + WS_CT) + (size_t)item * MLD * MLD; const bf16* INTRA = (const bf16*)(P.ws + WS_INTRA);
    const bf16* MOb = (const bf16*)(P.ws + WS_MO); const float* NP = (const float*)(P.ws + WS_NPREV) + (size_t)item * MLD; const float* DENI = (const float*)(P.ws + WS_DENI);
    bf16* Y = (bf16*)((unsigned char*)P.out + OUT_Y);
    __syncthreads();
    load_tile256(R1, Q + (size_t)r0 * MLW + ch0, MLW, 128, F.tid);
    if (F.tid < 256) SM[S_NPREV + F.tid] = NP[F.tid];
    gates_setup(F, P, SM, b, h, n, n);
    gates_rows(F, SM, n);
    const int fr = F.lane & 15, fq = F.lane >> 4, wm = F.wave >> 1, wn = F.wave & 1;
    {
        const int t = 16 * F.wave + fr; float s = 0.f;
#pragma unroll
        for (int c = 0; c < 8; ++c) { float f[8]; const u32x4 a = *(const LAS u32x4*)(R1 + t * P264 + 64 * fq + 8 * c); unpack8(a, f);
#pragma unroll
            for (int e = 0; e < 8; ++e) s += f[e] * SM[S_NPREV + 64 * fq + 8 * c + e]; }
        s += __shfl_xor(s, 16); s += __shfl_xor(s, 32);
        if (fq == 0) SM[S_QN + t] = s;
    }
    f32x4 hv[2][2][4];
#pragma unroll
    for (int eh = 0; eh < 2; ++eh) {
        __syncthreads();
        load_tile256(R2, CT + (size_t)eh * 128 * MLD, MLD, 128, F.tid);
        __syncthreads();
        zero_acc(hv[eh]);
        lds_mma_t<2, 4>(hv[eh], R1, P264, R2, P264, 32 * wm, 64 * wn, MLD, F.lane);
    }
    float mean[2], rstd[2];
#pragma unroll
    for (int mi = 0; mi < 2; ++mi) { const int t = 32 * wm + 16 * mi + fr, row = r0 + t; const float wi = SM[S_WINT + t], den = wi * SM[S_QN + t] + DENI[(size_t)row * 4 + h];
        const float inv = frcp(fmaxf(fabsf(den), __expf(-SM[S_MT + t]))); float s = 0.f;
#pragma unroll
        for (int eh = 0; eh < 2; ++eh)
#pragma unroll
            for (int ni = 0; ni < 4; ++ni) { const int e = eh * 128 + 64 * wn + 16 * ni + 4 * fq; float it[4]; { const u32x2 a = *(const u32x2*)(INTRA + (size_t)row * MLW + ch0 + e); unpack4(a, it); }
#pragma unroll
                for (int j = 0; j < 4; ++j) { const float v = (wi * hv[eh][mi][ni][j] + it[j]) * inv; hv[eh][mi][ni][j] = v; s += v; } }
        s += __shfl_xor(s, 16); s += __shfl_xor(s, 32);
        if (fq == 0) SM[S_STAT + 2 * t + wn] = s; }
    __syncthreads();
#pragma unroll
    for (int mi = 0; mi < 2; ++mi) { const int t = 32 * wm + 16 * mi + fr; mean[mi] = (SM[S_STAT + 2 * t] + SM[S_STAT + 2 * t + 1]) * (1.f / MLD); }
    __syncthreads();
#pragma unroll
    for (int mi = 0; mi < 2; ++mi) { const int t = 32 * wm + 16 * mi + fr; float s = 0.f;
#pragma unroll
        for (int eh = 0; eh < 2; ++eh)
#pragma unroll
            for (int ni = 0; ni < 4; ++ni)
#pragma unroll
                for (int j = 0; j < 4; ++j) { const float d = hv[eh][mi][ni][j] - mean[mi]; s += d * d; }
        s += __shfl_xor(s, 16); s += __shfl_xor(s, 32);
        if (fq == 0) SM[S_STAT + 2 * t + wn] = s; }
    __syncthreads();
#pragma unroll
    for (int mi = 0; mi < 2; ++mi) { const int t = 32 * wm + 16 * mi + fr, row = r0 + t; rstd[mi] = __builtin_amdgcn_rsqf((SM[S_STAT + 2 * t] + SM[S_STAT + 2 * t + 1]) * (1.f / MLD) + EPS);
#pragma unroll
        for (int eh = 0; eh < 2; ++eh)
#pragma unroll
            for (int ni = 0; ni < 4; ++ni) { const int e = eh * 128 + 64 * wn + 16 * ni + 4 * fq; float og[4]; { const u32x2 a = *(const u32x2*)(MOb + (size_t)row * MLW + ch0 + e); unpack4(a, og); }
                const f32x4 g = *(const f32x4*)(P.ml_norm_g + ch0 + e); float o[4];
#pragma unroll
                for (int j = 0; j < 4; ++j) o[j] = og[j] * ((hv[eh][mi][ni][j] - mean[mi]) * rstd[mi] * g[j]);
                u32x2 w; w.x = cvt_pk_bf16(o[0], o[1]); w.y = cvt_pk_bf16(o[2], o[3]); *(u32x2*)(Y + blk(row, GMW + ch0 + e, M)) = w; } }
    __syncthreads();
}

DI void p10_final(const Frame& F, const Ptrs& P) {
    const int gw = F.vcu * 8 + F.wave, NGW = F.G * 8;
    for (int m = gw; m < M; m += NGW) {
        GAS f32x4* xr = (GAS f32x4*)(P.out + (size_t)m * DM) + F.lane; f32x4 v[8]; float s2 = 0.f;
#pragma unroll
        for (int j = 0; j < 8; ++j) { v[j] = xr[64 * j]; s2 += (v[j].x * v[j].x + v[j].y * v[j].y) + (v[j].z * v[j].z + v[j].w * v[j].w); }
        const float rstd = __builtin_amdgcn_rsqf(wave_sum(s2) * (1.f / DM) + EPS);
#pragma unroll
        for (int j = 0; j < 8; ++j) { const f32x4 g = *(const f32x4*)(P.norm_f_g + 256 * j + 4 * F.lane); xr[64 * j] = v[j] * rstd * g; }
    }
}

constexpr int N_PHASES = 11;
struct Args { Ptrs p; int ph_lo, ph_hi, li, pad; };
__global__ void __launch_bounds__(512, 2) hybrid_fwd(Args args) {
    extern __shared__ __attribute__((aligned(16))) unsigned char lds[];
    Frame F; F.lds = (LAS unsigned char*)lds; F.tid = threadIdx.x; F.lane = F.tid & 63; F.wave = __builtin_amdgcn_readfirstlane(F.tid >> 6);
    F.G = gridDim.x; { const int bx = blockIdx.x; F.vcu = (F.G % 8 == 0) ? (bx % 8) * (F.G / 8) + bx / 8 : bx; }
    typedef const __attribute__((address_space(4))) unsigned char* KArgP;
    const KArgP ap0 = (KArgP)__builtin_amdgcn_kernarg_segment_ptr(); (void)args;
#define PHASE_ARGS KArgP ap = ap0; asm volatile("" : "+s"(ap)); Ptrs P; __builtin_memcpy(&P, ap, sizeof(Ptrs)); unsigned char* ws = P.ws; (void)ws
    unsigned char* ws0; { PHASE_ARGS; ws0 = ws; }
    volatile LAS unsigned* MISC = (volatile LAS unsigned*)(F.lds + MISC_OFF);
    if (F.tid < 64) MISC[F.tid] = 0u;
    __syncthreads();
    const int lo = args.ph_lo, hi = args.ph_hi;
    XcdBarrier bar; bar.bar = (unsigned*)(ws0 + WS_CTL) + CW_BAR + args.li * XCD_BAR_WORDS; bar.x = 0; bar.st = nullptr;
    if (hi - lo > 1) bar = xcd_barrier_post((unsigned*)(ws0 + WS_CTL) + CW_BAR + args.li * XCD_BAR_WORDS, MISC + 8);
#ifndef PHASE_MASK
#define PHASE_MASK 0x7ff
#endif
#define IN(k) (((PHASE_MASK >> (k)) & 1) && lo <= (k) && (k) < hi)
#define SEAM(k) do { if (IN(k) && IN((k) + 1)) xcd_barrier(bar); } while (0)
    using namespace pg8;
    if (IN(0)) { PHASE_ARGS; p0_prologue(F, P); } SEAM(0);
    if (IN(1)) { PHASE_ARGS;
        Gemm g{(const bf16_t*)((unsigned char*)P.out + OUT_XB), (const bf16_t*)(ws + WS_WIN), M, NPROJ, DM}; StaticOrder S; S.init(M, NPROJ, F.G, (int)blockIdx.x);
        EpiProj E{(const float*)(ws + WS_RSTD1), P.b_gate, (bf16_t*)(ws + WS_U), (bf16_t*)(ws + WS_GV), (bf16_t*)(ws + WS_MM), (bf16_t*)(ws + WS_MV), (bf16_t*)(ws + WS_MO), (bf16_t*)(ws + WS_GA), (bf16_t*)(ws + WS_GB), (float*)(ws + WS_LNSTAT)};
        gemm_phase<EpiProj, StaticOrder, true>(F.lds, g, S, E);
    } SEAM(1);
    if (IN(2)) { PHASE_ARGS;
        for (int it = F.vcu; it < BATCH * MLH * NCH; it += F.G) p2_qk_item(F, P, it);
        for (int it = F.vcu; it < BATCH * NCH * GMG; it += F.G) p2_gmlp_item(F, P, it);
    } SEAM(2);
    if (IN(3)) { PHASE_ARGS; for (int it = F.vcu; it < BATCH * MLH * NCH; it += F.G) p3_item(F, P, it); } SEAM(3);
    if (IN(4)) { PHASE_ARGS; for (int u = F.vcu; u < BATCH * MLH * 32; u += F.G) p4_scan_unit(F, P, u); } SEAM(4);
    if (IN(5)) { PHASE_ARGS; for (int it = F.vcu; it < BATCH * MLH * NCH; it += F.G) p5_item(F, P, it); } SEAM(5);
    if (IN(6)) { PHASE_ARGS;
        Gemm g{(const bf16_t*)((unsigned char*)P.out + OUT_Y), (const bf16_t*)(ws + WS_WAB), M, DM, DM}; StaticOrder S; S.init(M, DM, F.G, (int)blockIdx.x);
        EpiMix E{(const bf16_t*)(ws + WS_GA), (const bf16_t*)(ws + WS_GB), (bf16_t*)(ws + WS_MIXED)};
        gemm_phase<EpiMix, StaticOrder, true>(F.lds, g, S, E);
    } SEAM(6);
    if (IN(7)) { PHASE_ARGS;
        Gemm g{(const bf16_t*)(ws + WS_MIXED), (const bf16_t*)(ws + WS_WOUT), M, DM, DM}; StaticOrder S; S.init(M, DM, F.G, (int)blockIdx.x);
        EpiRes E{P.x, P.out, (bf16_t*)(ws + WS_X1B), (float*)(ws + WS_X1SS)};
        gemm_phase<EpiRes, StaticOrder, true>(F.lds, g, S, E);
    } SEAM(7);
    if (IN(8)) { PHASE_ARGS;
        Gemm g{(const bf16_t*)(ws + WS_X1B), (const bf16_t*)(ws + WS_WFF1), M, DFF, DM}; StaticOrder S; S.init(M, DFF, F.G, (int)blockIdx.x);
        EpiFF1 E{(const float*)(ws + WS_X1SS), (bf16_t*)(ws + WS_H)};
        gemm_phase<EpiFF1, StaticOrder, true>(F.lds, g, S, E);
    } SEAM(8);
    if (IN(9)) { PHASE_ARGS;
        Gemm g{(const bf16_t*)(ws + WS_H), (const bf16_t*)(ws + WS_WFF2), M, DM, DFF}; StaticOrder S; S.init(M, DM, F.G, (int)blockIdx.x);
        EpiRes E{P.out, P.out, nullptr, nullptr};
        gemm_phase<EpiRes, StaticOrder, true>(F.lds, g, S, E);
    } SEAM(9);
    if (IN(10)) { PHASE_ARGS; p10_final(F, P); }
#undef IN
#undef SEAM
}


extern "C" void kernel_launch(void* const* d_in, const int* in_sizes, int n_in, void* d_out, int out_size, void* d_ws, size_t ws_size, hipStream_t stream) {
    static int grid = 0;
    if (grid == 0) {
        if (n_in != 22 || in_sizes[0] != M * DM || out_size != M * DM || ws_size < WS_END) { fprintf(stderr, "kernel_launch: unexpected shapes (n_in %d, in0 %d, out %d, ws %zu < %zu); nothing launched\n", n_in, n_in > 0 ? in_sizes[0] : -1, out_size, ws_size, (size_t)WS_END); grid = -1; return; }
        int dev = 0, cus = 0;
        if (hipGetDevice(&dev) != hipSuccess || hipDeviceGetAttribute(&cus, hipDeviceAttributeMultiprocessorCount, dev) != hipSuccess) { grid = -1; return; }
        if (hipFuncSetAttribute((const void*)hybrid_fwd, hipFuncAttributeMaxDynamicSharedMemorySize, LDS_BYTES) != hipSuccess) { fprintf(stderr, "kernel_launch: hipFuncSetAttribute failed\n"); grid = -1; return; }
        int per_cu = 0; (void)hipOccupancyMaxActiveBlocksPerMultiprocessor(&per_cu, (const void*)hybrid_fwd, 512, LDS_BYTES); (void)hipGetLastError();
        grid = cus;
        if (per_cu < 1) fprintf(stderr, "kernel_launch: occupancy query reports %d blocks per CU\n", per_cu);
    }
    if (grid < 0) return;
    (void)hipMemsetAsync((char*)d_ws + WS_CTL, 0, CTL_ZERO_BYTES, stream);
    Args a{};
    const float** pp = (const float**)&a.p;
    for (int i = 0; i < 22; ++i) pp[i] = (const float*)d_in[i];
    a.p.out = (float*)d_out; a.p.ws = (unsigned char*)d_ws;
#ifdef PROBE_LO
    a.ph_lo = 0; a.ph_hi = PROBE_HI; hipLaunchKernelGGL(hybrid_fwd, dim3(grid), dim3(512), LDS_BYTES, stream, a);
    a.li = 1; a.ph_lo = PROBE_LO; a.ph_hi = PROBE_HI; hipLaunchKernelGGL(hybrid_fwd, dim3(grid), dim3(512), LDS_BYTES, stream, a);
    if (PROBE_HI < N_PHASES) { a.li = 2; a.ph_lo = PROBE_HI; a.ph_hi = N_PHASES; hipLaunchKernelGGL(hybrid_fwd, dim3(grid), dim3(512), LDS_BYTES, stream, a); }
    return;
#endif
    if (MK_N_LAUNCHES == 1) { a.ph_lo = 0; a.ph_hi = N_PHASES; hipLaunchKernelGGL(hybrid_fwd, dim3(grid), dim3(512), LDS_BYTES, stream, a); }
    else { for (int ph = 0; ph < N_PHASES; ++ph) { a.ph_lo = ph; a.ph_hi = ph + 1; hipLaunchKernelGGL(hybrid_fwd, dim3(grid), dim3(512), LDS_BYTES, stream, a); } }
}
```
